# Optimizing an MI355X kernel written in HIP

```python
import math
import jax
import jax.numpy as jnp
from jax import lax
import numpy as np

D_MODEL = 1024
BATCH = 16
SEQ = 2048
DEPTH = 4

GRID_W = 64
CTX_LEN = 256

HEAD_DIM = 64
N_Q_HEADS = 8
N_KV_HEADS = 2
Q_GROUP = N_Q_HEADS // N_KV_HEADS
ATT_Q_W = N_Q_HEADS * HEAD_DIM
ATT_KV_W = N_KV_HEADS * HEAD_DIM
Q_BLOCK = 128
ROPE_THETA = 10000.0
ROPE_AXIS_DIM = HEAD_DIM // 2

HY_W = D_MODEL // 4
HY_ORDER = 2
HY_SHORT = 3
HY_BANDS = 16
HY_EMB = 2 * HY_BANDS + 1
HY_FFN = 64
HY_DECAY_TARGET = 1e-2
HY_DECAY_SHORT_PCT = 0.3
HY_DECAY_LONG_PCT = 1.5

FN_GROUPS = 4
FN_GROUP_W = D_MODEL // 16
FN_W = FN_GROUPS * FN_GROUP_W

MIX_W = ATT_Q_W + HY_W + FN_W
N_BRANCH = 3

OFF_Q = 0
OFF_K = OFF_Q + ATT_Q_W
OFF_V = OFF_K + ATT_KV_W
OFF_HY = OFF_V + ATT_KV_W
OFF_FN = OFF_HY + (HY_ORDER + 1) * HY_W
OFF_GATE = OFF_FN + FN_W
IN_W = OFF_GATE + N_BRANCH * D_MODEL

N_EXPERTS = 16
EXPERT_FF = 2 * D_MODEL
CAPACITY_FACTOR = 2

EPS = 1e-6

kernel_name = "hybrid_hyena_fnet_gqa_ecmoe_dit"


def rms_norm(x, g):
    xf = x.astype(jnp.float32)
    y = xf * lax.rsqrt(jnp.mean(xf * xf, axis=-1, keepdims=True) + EPS)
    return (y * g.astype(jnp.float32)).astype(x.dtype)


def modulate(h, shift, scale):
    return h * (1.0 + scale) + shift


def axial_rope_tables(n_tokens):
    rows = n_tokens // GRID_W
    row = jnp.repeat(jnp.arange(rows, dtype=jnp.float32), GRID_W)
    col = jnp.tile(jnp.arange(GRID_W, dtype=jnp.float32), rows)
    inv = ROPE_THETA ** (-jnp.arange(0, ROPE_AXIS_DIM, 2, dtype=jnp.float32) / ROPE_AXIS_DIM)
    ang = jnp.concatenate([row[:, None] * inv, col[:, None] * inv], axis=-1)
    return jnp.cos(ang), jnp.sin(ang)


def apply_rope(u, cos, sin):
    uf = u.astype(jnp.float32).reshape(*u.shape[:-1], HEAD_DIM // 2, 2)
    u0, u1 = uf[..., 0], uf[..., 1]
    c = cos[None, :, None, :]
    s = sin[None, :, None, :]
    out = jnp.stack([u0 * c - u1 * s, u0 * s + u1 * c], axis=-1)
    return out.reshape(u.shape).astype(u.dtype)


def qk_heads(u, n_heads, gain, rope):
    b, n, _ = u.shape
    u = rms_norm(u.reshape(b, n, n_heads, HEAD_DIM), gain)
    if rope is not None:
        u = apply_rope(u, rope[0], rope[1])
    return u


def block_attention(q, k, v):
    b, n = q.shape[0], q.shape[1]
    nb = n // Q_BLOCK
    qb = q.reshape(b, nb, Q_BLOCK, N_KV_HEADS, Q_GROUP, HEAD_DIM).transpose(1, 0, 2, 3, 4, 5)
    scale = HEAD_DIM ** -0.5

    def attend(qblk):
        s = jnp.einsum('bqkgd,bskd->bkgqs', qblk, k, preferred_element_type=jnp.float32) * scale
        p = jax.nn.softmax(s, axis=-1).astype(v.dtype)
        return jnp.einsum('bkgqs,bskd->bqkgd', p, v)

    o = lax.map(attend, qb)
    return o.transpose(1, 0, 2, 3, 4, 5).reshape(b, n, ATT_Q_W)


def short_conv(u, w, b):
    n = u.shape[1]
    pad = HY_SHORT // 2
    up = jnp.pad(u, ((0, 0), (pad, pad), (0, 0)))
    out = b
    for j in range(HY_SHORT):
        out = out + up[:, j:j + n] * w[j]
    return out


def hyena_spectrum(n, w1, b1, w2, b2, w3, freq):
    f32 = jnp.float32
    w1, b1, w2, b2, w3, freq = (a.astype(f32) for a in (w1, b1, w2, b2, w3, freq))
    pos = jnp.arange(n, dtype=f32)
    t = pos / (n - 1)
    bands = jnp.linspace(1e-4, HY_BANDS - 1, HY_BANDS, dtype=f32)
    ang = (2.0 * math.pi / n) * pos[:, None] * bands[None, :]
    feats = jnp.concatenate([t[:, None], jnp.cos(ang), -jnp.sin(ang)], axis=-1)
    h = jnp.sin(freq * (feats @ w1 + b1))
    h = jnp.sin(freq * (h @ w2 + b2))
    h = (h @ w3).reshape(n, 2, HY_ORDER, HY_W)
    deltas = jnp.abs(jnp.linspace(math.log(HY_DECAY_TARGET) / HY_DECAY_LONG_PCT,
                                  math.log(HY_DECAY_TARGET) / HY_DECAY_SHORT_PCT, HY_W, dtype=f32))
    h = h * jnp.exp(-t[:, None] * deltas[None, :])[:, None, None, :]
    filt = jnp.concatenate([h[:, 0], jnp.zeros((1, HY_ORDER, HY_W), f32), h[1:, 1][::-1]], axis=0)
    filt = filt / jnp.sum(jnp.abs(filt), axis=0, keepdims=True)
    return jnp.fft.rfft(filt, axis=0)


def long_conv(z, spec, d):
    n = z.shape[1]
    zf = z.astype(jnp.float32)
    y = jnp.fft.irfft(jnp.fft.rfft(zf, n=2 * n, axis=1) * spec[None], n=2 * n, axis=1)[:, :n]
    return (y + zf * d.astype(jnp.float32)).astype(z.dtype)


def hyena_mixer(u, sw, sb, spec, bias):
    u = short_conv(u, sw, sb)
    v, g1, g2 = jnp.split(u, HY_ORDER + 1, axis=-1)
    z = g1 * long_conv(v, spec[:, 0], bias[0])
    return g2 * long_conv(z, spec[:, 1], bias[1])


def fourier_mix(u):
    b, n, _ = u.shape
    ug = u.astype(jnp.float32).reshape(b, n, FN_GROUPS, FN_GROUP_W)
    y = jnp.fft.fft2(ug, axes=(1, 3), norm='ortho').real
    return y.reshape(b, n, FN_W).astype(u.dtype)


def merge_branches(att, hy, fn, gates, w_branch, w_out):
    ga, gh, gf = jnp.split(gates, N_BRANCH, axis=-1)
    ya = att @ w_branch[:ATT_Q_W]
    yh = hy @ w_branch[ATT_Q_W:ATT_Q_W + HY_W]
    yf = fn @ w_branch[ATT_Q_W + HY_W:]
    m = jax.nn.sigmoid(ga) * ya + jax.nn.sigmoid(gh) * yh + jax.nn.sigmoid(gf) * yf
    return m @ w_out


def mixer_sublayer(h, k_ext, v_ext, rope, w_in, q_gain, k_gain, sw, sb, spec, hy_bias, w_branch, w_out):
    b, n, _ = h.shape
    p = h @ w_in
    q = qk_heads(p[..., OFF_Q:OFF_K], N_Q_HEADS, q_gain, rope)
    k = qk_heads(p[..., OFF_K:OFF_V], N_KV_HEADS, k_gain, rope)
    v = p[..., OFF_V:OFF_HY].reshape(b, n, N_KV_HEADS, HEAD_DIM)
    if k_ext is None:
        att = block_attention(q, k, v)
    else:
        att = block_attention(q, jnp.concatenate([k, k_ext], axis=1), jnp.concatenate([v, v_ext], axis=1))
    hy = hyena_mixer(p[..., OFF_HY:OFF_FN], sw, sb, spec, hy_bias)
    fn = fourier_mix(p[..., OFF_FN:OFF_GATE])
    return merge_branches(att, hy, fn, p[..., OFF_GATE:], w_branch, w_out), k, v


def expert_choice_moe(h, w_router, w_gate, w_up, w_down):
    b, n, d = h.shape
    cap = CAPACITY_FACTOR * n // N_EXPERTS
    logits = jnp.einsum('bld,de->ble', h, w_router, preferred_element_type=jnp.float32)
    aff = jax.nn.softmax(logits, axis=-1)
    top_w, top_i = lax.top_k(aff.transpose(0, 2, 1), cap)
    xg = jax.vmap(lambda hb, ib: hb[ib])(h, top_i)
    a = jnp.einsum('becd,edf->becf', xg, w_gate)
    u = jnp.einsum('becd,edf->becf', xg, w_up)
    y = jnp.einsum('becf,efd->becd', jax.nn.silu(a) * u, w_down)
    y = y * top_w[..., None].astype(y.dtype)
    return jax.vmap(lambda yb, ib: jnp.zeros((n, d), y.dtype).at[ib.reshape(-1)].add(yb.reshape(-1, d)))(y, top_i)


def setup_inputs(seed: int = 0) -> dict:
    key = jax.random.key(seed)
    ks = jax.random.split(key, 27)
    f32 = jnp.float32
    D = D_MODEL

    def nrm(k, shape, scale):
        return jax.random.normal(k, shape, f32) * scale

    return {
        "x": nrm(ks[0], (BATCH, SEQ, D), 1.0),
        "c": nrm(ks[1], (BATCH, D), 1.0),
        "ctx": nrm(ks[2], (BATCH, CTX_LEN, D), 1.0),
        "c_ctx": nrm(ks[3], (D,), 1.0),
        "w_mod": nrm(ks[4], (DEPTH, D, 6 * D), 0.5 * D ** -0.5),
        "b_mod": nrm(ks[5], (DEPTH, 6 * D), 0.02),
        "norm1_g": 1.0 + nrm(ks[6], (DEPTH, D), 0.02),
        "norm2_g": 1.0 + nrm(ks[7], (DEPTH, D), 0.02),
        "w_in": nrm(ks[8], (DEPTH, D, IN_W), D ** -0.5),
        "q_gain": 1.0 + nrm(ks[9], (DEPTH, HEAD_DIM), 0.02),
        "k_gain": 1.0 + nrm(ks[10], (DEPTH, HEAD_DIM), 0.02),
        "hy_short_w": nrm(ks[11], (DEPTH, HY_SHORT, (HY_ORDER + 1) * HY_W), HY_SHORT ** -0.5),
        "hy_short_b": nrm(ks[12], (DEPTH, (HY_ORDER + 1) * HY_W), 0.02),
        "hy_f_w1": nrm(ks[13], (DEPTH, HY_EMB, HY_FFN), HY_EMB ** -0.5),
        "hy_f_b1": nrm(ks[14], (DEPTH, HY_FFN), 0.1),
        "hy_f_w2": nrm(ks[15], (DEPTH, HY_FFN, HY_FFN), HY_FFN ** -0.5),
        "hy_f_b2": nrm(ks[16], (DEPTH, HY_FFN), 0.1),
        "hy_f_w3": nrm(ks[17], (DEPTH, HY_FFN, 2 * HY_ORDER * HY_W), HY_FFN ** -0.5),
        "hy_f_freq": 1.0 + nrm(ks[18], (DEPTH, HY_FFN), 0.02),
        "hy_bias": nrm(ks[19], (DEPTH, HY_ORDER, HY_W), 1.0),
        "w_branch": nrm(ks[20], (DEPTH, MIX_W, D), (MIX_W // 4) ** -0.5),
        "w_out": nrm(ks[21], (DEPTH, D, D), D ** -0.5),
        "w_router": nrm(ks[22], (DEPTH, D, N_EXPERTS), D ** -0.5),
        "w_gate": nrm(ks[23], (DEPTH, N_EXPERTS, D, EXPERT_FF), D ** -0.5),
        "w_up": nrm(ks[24], (DEPTH, N_EXPERTS, D, EXPERT_FF), D ** -0.5),
        "w_down": nrm(ks[25], (DEPTH, N_EXPERTS, EXPERT_FF, D), EXPERT_FF ** -0.5),
        "final_g": 1.0 + nrm(ks[26], (D,), 0.02),
    }


def reference(x, c, ctx, c_ctx, w_mod, b_mod, norm1_g, norm2_g, w_in, q_gain, k_gain,
              hy_short_w, hy_short_b, hy_f_w1, hy_f_b1, hy_f_w2, hy_f_b2, hy_f_w3, hy_f_freq,
              hy_bias, w_branch, w_out, w_router, w_gate, w_up, w_down, final_g):
    n_lat = x.shape[1]
    n_ctx = ctx.shape[1]
    rope = axial_rope_tables(n_lat)
    sc = jax.nn.silu(c)
    scc = jax.nn.silu(c_ctx)
    for l in range(DEPTH):
        last = l == DEPTH - 1
        mx = (sc @ w_mod[l] + b_mod[l])[:, None, :]
        mc = scc @ w_mod[l] + b_mod[l]
        sh1, sc1, g1, sh2, sc2, g2 = jnp.split(mx, 6, axis=-1)
        csh1, csc1, cg1, csh2, csc2, cg2 = jnp.split(mc, 6, axis=-1)

        hc = modulate(rms_norm(ctx, norm1_g[l]), csh1, csc1)
        if last:
            pkv = hc @ w_in[l][:, OFF_K:OFF_HY]
            kc = qk_heads(pkv[..., :ATT_KV_W], N_KV_HEADS, k_gain[l], None)
            vc = pkv[..., ATT_KV_W:].reshape(ctx.shape[0], n_ctx, N_KV_HEADS, HEAD_DIM)
        else:
            spec_c = hyena_spectrum(n_ctx, hy_f_w1[l], hy_f_b1[l], hy_f_w2[l], hy_f_b2[l], hy_f_w3[l], hy_f_freq[l])
            yc, kc, vc = mixer_sublayer(hc, None, None, None, w_in[l], q_gain[l], k_gain[l],
                                        hy_short_w[l], hy_short_b[l], spec_c, hy_bias[l], w_branch[l], w_out[l])

        spec_x = hyena_spectrum(n_lat, hy_f_w1[l], hy_f_b1[l], hy_f_w2[l], hy_f_b2[l], hy_f_w3[l], hy_f_freq[l])
        hx = modulate(rms_norm(x, norm1_g[l]), sh1, sc1)
        yx, _, _ = mixer_sublayer(hx, kc, vc, rope, w_in[l], q_gain[l], k_gain[l],
                                  hy_short_w[l], hy_short_b[l], spec_x, hy_bias[l], w_branch[l], w_out[l])
        x = x + g1 * yx
        h2 = modulate(rms_norm(x, norm2_g[l]), sh2, sc2)
        x = x + g2 * expert_choice_moe(h2, w_router[l], w_gate[l], w_up[l], w_down[l])

        if not last:
            ctx = ctx + cg1 * yc
            hc2 = modulate(rms_norm(ctx, norm2_g[l]), csh2, csc2)
            ctx = ctx + cg2 * expert_choice_moe(hc2, w_router[l], w_gate[l], w_up[l], w_down[l])
    return rms_norm(x, final_g)
```

```cpp
#include <hip/hip_runtime.h>
#include <stdint.h>
#include <string.h>

#define LAS __attribute__((address_space(3)))
typedef unsigned short bf16_t;
typedef short bf16x8 __attribute__((ext_vector_type(8)));
typedef float f32x4 __attribute__((ext_vector_type(4)));
typedef unsigned u32x4 __attribute__((ext_vector_type(4)));
typedef unsigned u32x2 __attribute__((ext_vector_type(2)));

constexpr int DM = 1024, NBATCH = 16, LSEQ = 2048, LCTX = 256, TPB = 2304, NTOK = 36864, NLAYER = 4;
constexpr int INW = 4864, OFF_HY = 768, OFF_FN = 1536, OFF_GATE = 1792;
constexpr int PMW = 3840;
constexpr int SWR = 1280;
constexpr int NEXP = 16, FF = 2048, CAP_L = 256, CAP_C = 32, EROWS = 4608;
constexpr int NT = 512;
constexpr float EPS = 1e-6f;

constexpr size_t al256(size_t x) { return (x + 255) & ~(size_t)255; }
constexpr size_t O_BAR   = 0;
constexpr size_t O_WINM  = 65536;
constexpr size_t O_WINS  = O_WINM + (size_t)NLAYER * PMW * DM * 2;
constexpr size_t O_WBT   = O_WINS + (size_t)NLAYER * SWR * DM * 2;
constexpr size_t O_WOT   = O_WBT + (size_t)NLAYER * DM * DM * 2;
constexpr size_t O_WGU   = O_WOT + (size_t)NLAYER * DM * DM * 2;
constexpr size_t O_WDT   = O_WGU + (size_t)NLAYER * NEXP * 4096 * DM * 2;
constexpr size_t O_MODV  = O_WDT + (size_t)NLAYER * NEXP * DM * FF * 2;
constexpr size_t O_ROPE  = al256(O_MODV + (size_t)NLAYER * 17 * 6144 * 4);
constexpr size_t O_HRAW  = O_ROPE + (size_t)LSEQ * 32 * 2 * 4;
constexpr size_t O_GFL   = O_HRAW + (size_t)NLAYER * TPB * 1024 * 4;
constexpr size_t O_GFC   = O_GFL + (size_t)NLAYER * 2 * 256 * 4096 * 2;
constexpr size_t O_DFTM  = O_GFC + (size_t)NLAYER * 2 * 256 * 512 * 2;
constexpr size_t O_DFTC  = O_DFTM + (size_t)LSEQ * 4096 * 2;
constexpr size_t O_XS    = O_DFTC + (size_t)LCTX * 512 * 2;
constexpr size_t O_H     = O_XS + (size_t)NTOK * DM * 4;
constexpr size_t O_PM    = O_H + (size_t)NTOK * DM * 2;
constexpr size_t O_HYT   = O_PM + (size_t)NTOK * PMW * 2;
constexpr size_t O_HYTC  = O_HYT + (size_t)768 * NBATCH * LSEQ * 2;
constexpr size_t O_PQT   = O_HYTC + (size_t)768 * NBATCH * LCTX * 2;
constexpr size_t O_PQTC  = O_PQT + (size_t)NBATCH * 256 * 4096 * 2;
constexpr size_t O_QP    = O_PQTC + (size_t)NBATCH * 256 * 512 * 2;
constexpr size_t O_KP    = O_QP + (size_t)NTOK * 512 * 2;
constexpr size_t O_MIX   = O_KP + (size_t)NTOK * 128 * 2;
constexpr size_t O_M     = O_MIX + (size_t)NTOK * DM * 2;
constexpr size_t O_Y     = O_M + (size_t)NTOK * DM * 2;
constexpr size_t O_AFF   = O_Y + (size_t)NTOK * DM * 4;
constexpr size_t O_SEL   = O_AFF + (size_t)NTOK * 16 * 4;
constexpr size_t O_IDX   = O_SEL + (size_t)NTOK * 16 * 4;
constexpr size_t O_END   = O_IDX + (size_t)NEXP * EROWS * 4;
constexpr size_t O_HID   = O_PM;
static_assert((size_t)NEXP * EROWS * FF * 2 <= O_PQT - O_PM, "hidden alias fits");
static_assert((size_t)NEXP * EROWS * DM * 2 <= (size_t)NTOK * DM * 4, "Y fits in macc region");
static_assert(O_END <= (size_t)2147483648ull, "workspace fits 2 GiB");

struct Prm {
    const float *x, *c, *ctx, *c_ctx, *w_mod, *b_mod, *norm1_g, *norm2_g, *w_in, *q_gain, *k_gain, *hy_sw, *hy_sb,
        *hy_w1, *hy_b1, *hy_w2, *hy_b2, *hy_w3, *hy_freq, *hy_bias, *w_branch, *w_out, *w_router, *w_gate, *w_up, *w_down, *final_g;
    float* out;
    unsigned char* ws;
};

__device__ __forceinline__ unsigned f2bf(float f) { unsigned u = __float_as_uint(f); return (u + 0x7fffu + ((u >> 16) & 1u)) >> 16; }
__device__ __forceinline__ unsigned pk2(float lo, float hi) { return f2bf(lo) | (f2bf(hi) << 16); }
__device__ __forceinline__ float bf2f(bf16_t b) { return __uint_as_float((unsigned)b << 16); }
__device__ __forceinline__ float bflo(unsigned w) { return __uint_as_float(w << 16); }
__device__ __forceinline__ float bfhi(unsigned w) { return __uint_as_float(w & 0xffff0000u); }
__device__ __forceinline__ float wave_sum(float v) {
#pragma unroll
    for (int o = 32; o >= 1; o >>= 1) v += __shfl_xor(v, o);
    return v;
}
__device__ __forceinline__ float sigmoidf_(float v) { return 1.0f / (1.0f + __expf(-v)); }

constexpr int BM = 256, BK = 64, HALF = 128, HTB = HALF * BK * 2;
__device__ __forceinline__ int lds_byte(int r, int c) { const int st = (r >> 4) * 2 + (c >> 5), rr = r & 15, cc = c & 31, ob = rr * 64 + cc * 2; return st * 1024 + (ob ^ (((ob >> 9) & 1) << 5)); }
__device__ __forceinline__ void stage_rc(int b, int& R, int& C) { const int st = b / 1024, sb = b % 1024, swz = sb ^ (((sb >> 9) & 1) << 5); R = (st >> 1) * 16 + swz / 64; C = (st & 1) * 32 + (swz % 64) / 2; }

struct GU {
    const bf16_t* A;
    const bf16_t* B;
    const int* gidx;
    int lda, ldb, nt;
    int i0, i1, i2, i3;
};

template <class Epi, class Sched>
__device__ __forceinline__ void gemm_simple(LAS unsigned char* lds, const Sched& S, const Epi& E) {
    const int tid = threadIdx.x, wid = tid >> 6, lane = tid & 63, wr = wid >> 2, wc = wid & 3, fr = lane & 15, fq = lane >> 4;
    int R[2], C[2];
#pragma unroll
    for (int i = 0; i < 2; ++i) stage_rc(tid * 16 + i * 8192, R[i], C[i]);
    const int aoff = lds_byte(wr * 64 + fr, fq * 8), boff = lds_byte(wc * 32 + fr, fq * 8);
    GU u;
    for (int ui = 0; S.next(ui, u); ++ui) {
        f32x4 acc[2][2][4][2];
#pragma unroll
        for (int a = 0; a < 2; ++a)
#pragma unroll
            for (int b = 0; b < 2; ++b)
#pragma unroll
                for (int m = 0; m < 4; ++m)
#pragma unroll
                    for (int n = 0; n < 2; ++n) acc[a][b][m][n] = (f32x4){0.f, 0.f, 0.f, 0.f};
        size_t arow[2][2];
#pragma unroll
        for (int h = 0; h < 2; ++h)
#pragma unroll
            for (int i = 0; i < 2; ++i) { const int row = h * HALF + R[i]; arow[h][i] = (size_t)(u.gidx ? u.gidx[row] : row) * u.lda + C[i]; }
        for (int kt = 0; kt < u.nt; ++kt) {
            u32x4 va[2][2], vb[2][2];
#pragma unroll
            for (int h = 0; h < 2; ++h)
#pragma unroll
                for (int i = 0; i < 2; ++i) {
                    va[h][i] = *(const u32x4*)(u.A + arow[h][i] + kt * BK);
                    vb[h][i] = *(const u32x4*)(u.B + (size_t)(h * HALF + R[i]) * u.ldb + C[i] + kt * BK);
                }
            __syncthreads();
#pragma unroll
            for (int h = 0; h < 2; ++h)
#pragma unroll
                for (int i = 0; i < 2; ++i) {
                    *(LAS u32x4*)(lds + h * HTB + tid * 16 + i * 8192) = va[h][i];
                    *(LAS u32x4*)(lds + (2 + h) * HTB + tid * 16 + i * 8192) = vb[h][i];
                }
            __syncthreads();
#pragma unroll
            for (int ai = 0; ai < 2; ++ai) {
                bf16x8 At[4][2];
#pragma unroll
                for (int m = 0; m < 4; ++m)
#pragma unroll
                    for (int k = 0; k < 2; ++k) At[m][k] = *(const LAS bf16x8*)(lds + ai * HTB + aoff + m * 2048 + k * 1024);
#pragma unroll
                for (int bj = 0; bj < 2; ++bj) {
                    bf16x8 Bf[2][2];
#pragma unroll
                    for (int n = 0; n < 2; ++n)
#pragma unroll
                        for (int k = 0; k < 2; ++k) Bf[n][k] = *(const LAS bf16x8*)(lds + (2 + bj) * HTB + boff + n * 2048 + k * 1024);
#pragma unroll
                    for (int m = 0; m < 4; ++m)
#pragma unroll
                        for (int n = 0; n < 2; ++n)
#pragma unroll
                            for (int k = 0; k < 2; ++k)
                                acc[ai][bj][m][n] = __builtin_amdgcn_mfma_f32_16x16x32_bf16(Bf[n][k], At[m][k], acc[ai][bj][m][n], 0, 0, 0);
                }
            }
        }
        E(acc, u, wr, wc, fr, fq);
        __syncthreads();
    }
}

#define EPI_FOREACH(...)                                                                          \
    _Pragma("unroll") for (int ai = 0; ai < 2; ++ai) _Pragma("unroll") for (int m = 0; m < 4; ++m) \
    _Pragma("unroll") for (int bj = 0; bj < 2; ++bj) _Pragma("unroll") for (int n = 0; n < 2; ++n) { \
        const int row = ai * HALF + wr * 64 + m * 16 + fr, col = bj * HALF + wc * 32 + n * 16 + 4 * fq; const f32x4 v = acc[ai][bj][m][n]; __VA_ARGS__ }

struct EpiPm {
    bf16_t* PM;
    __device__ __forceinline__ void operator()(const f32x4 (&acc)[2][2][4][2], const GU& u, int wr, int wc, int fr, int fq) const {
        const int r0 = u.i0 * BM, c0 = u.i1 * BM; const bool gate = c0 >= 768;
        EPI_FOREACH({ f32x4 w = v; if (gate) { w[0] = sigmoidf_(w[0]); w[1] = sigmoidf_(w[1]); w[2] = sigmoidf_(w[2]); w[3] = sigmoidf_(w[3]); }
            u32x2 o; o.x = pk2(w[0], w[1]); o.y = pk2(w[2], w[3]); *(u32x2*)(PM + (size_t)(r0 + row) * PMW + c0 + col) = o; })
    }
};
struct EpiSw {
    bf16_t *HYT, *HYTC, *PQT, *PQTC;
    __device__ __forceinline__ void operator()(const f32x4 (&acc)[2][2][4][2], const GU& u, int wr, int wc, int fr, int fq) const {
        const int pm = u.i0, pn = u.i1, b = pn / 9, j = pn % 9; const bool isctx = (j == 8);
        EPI_FOREACH({ u32x2 o; o.x = pk2(v[0], v[1]); o.y = pk2(v[2], v[3]);
            bf16_t* dst;
            if (pm < 3) { const int ch = pm * 256 + row; dst = isctx ? HYTC + ((size_t)ch * NBATCH + b) * LCTX + col : HYT + ((size_t)ch * NBATCH + b) * LSEQ + j * 256 + col; }
            else { const int ch = row, q = pm - 3; dst = isctx ? PQTC + ((size_t)b * 256 + ch) * 512 + q * 256 + col : PQT + ((size_t)b * 256 + ch) * 4096 + q * 2048 + j * 256 + col; }
            *(u32x2*)dst = o; })
    }
};
struct EpiBf {
    bf16_t* O; int ld;
    __device__ __forceinline__ void operator()(const f32x4 (&acc)[2][2][4][2], const GU& u, int wr, int wc, int fr, int fq) const {
        EPI_FOREACH({ u32x2 o; o.x = pk2(v[0], v[1]); o.y = pk2(v[2], v[3]); *(u32x2*)(O + (size_t)(u.i0 + row) * ld + u.i1 + col) = o; })
    }
};
struct EpiMerge {
    const bf16_t* PM; float* MACC; bf16_t* M;
    __device__ __forceinline__ void operator()(const f32x4 (&acc)[2][2][4][2], const GU& u, int wr, int wc, int fr, int fq) const {
        const int r0 = u.i0 * BM, c0 = u.i1 * BM, seg = u.i2;
        EPI_FOREACH({ const size_t r = r0 + row; const int c = c0 + col;
            const u32x2 g = *(const u32x2*)(PM + r * PMW + 768 + seg * 1024 + c);
            f32x4 w; w[0] = v[0] * bflo(g.x); w[1] = v[1] * bfhi(g.x); w[2] = v[2] * bflo(g.y); w[3] = v[3] * bfhi(g.y);
            float* mp = MACC + r * DM + c;
            if (seg > 0) { const f32x4 o = *(const f32x4*)mp; w += o; }
            if (seg < 2) *(f32x4*)mp = w; else { u32x2 o; o.x = pk2(w[0], w[1]); o.y = pk2(w[2], w[3]); *(u32x2*)(M + r * DM + c) = o; } })
    }
};
struct EpiRes {
    float* XS; const float* modl; int goff;
    __device__ __forceinline__ void operator()(const f32x4 (&acc)[2][2][4][2], const GU& u, int wr, int wc, int fr, int fq) const {
        const int r0 = u.i0 * BM, c0 = u.i1 * BM; const int pn9 = u.i0 % 9, b = u.i0 / 9; const int mrow = (pn9 == 8) ? 16 : b;
        EPI_FOREACH({ const size_t r = r0 + row; const int c = c0 + col; const f32x4 g = *(const f32x4*)(modl + (size_t)mrow * 6144 + goff + c);
            float* xp = XS + r * DM + c; f32x4 o = *(const f32x4*)xp; o += g * v; *(f32x4*)xp = o; })
    }
};
struct EpiGlu {
    bf16_t* HID;
    __device__ __forceinline__ void operator()(const f32x4 (&acc)[2][2][4][2], const GU& u, int wr, int wc, int fr, int fq) const {
#pragma unroll
        for (int ai = 0; ai < 2; ++ai)
#pragma unroll
            for (int m = 0; m < 4; ++m)
#pragma unroll
                for (int n = 0; n < 2; ++n) {
                    const int row = ai * HALF + wr * 64 + m * 16 + fr, col = wc * 32 + n * 16 + 4 * fq; const f32x4 g = acc[ai][0][m][n], up = acc[ai][1][m][n]; f32x4 w;
#pragma unroll
                    for (int j = 0; j < 4; ++j) w[j] = g[j] * sigmoidf_(g[j]) * up[j];
                    u32x2 o; o.x = pk2(w[0], w[1]); o.y = pk2(w[2], w[3]); *(u32x2*)(HID + (size_t)(u.i0 + row) * FF + u.i1 + col) = o; }
    }
};

struct SchedG1 {
    const bf16_t *H, *WM, *WS; int g, c;
    __device__ __forceinline__ bool next(int i, GU& u) const {
        const int L = i * g + c; if (L >= 144 * 20) return false;
        const int pn_all = L % 20, pmt = L / 20;
        u.gidx = nullptr; u.lda = DM; u.ldb = DM; u.nt = 16; u.i2 = 0; u.i3 = 0;
        if (pn_all < 15) { u.A = H + (size_t)pmt * BM * DM; u.B = WM + (size_t)pn_all * BM * DM; u.i0 = pmt; u.i1 = pn_all; u.i2 = 0; }
        else { u.A = WS + (size_t)(pn_all - 15) * BM * DM; u.B = H + (size_t)pmt * BM * DM; u.i0 = pn_all - 15; u.i1 = pmt; u.i2 = 1; }
        return true;
    }
};
struct SchedFn {
    const bf16_t *DFTM, *DFTC, *PQT, *PQTC; int g, c, nctx;
    __device__ __forceinline__ bool next(int i, GU& u) const {
        const int L = i * g + c; if (L >= 128 + nctx) return false;
        u.gidx = nullptr; u.i2 = 0; u.i3 = 0; u.i1 = 768;
        if (L < 128) { const int b = L >> 3, pm = L & 7; u.A = DFTM + (size_t)pm * BM * 4096; u.lda = 4096; u.B = PQT + (size_t)b * 256 * 4096; u.ldb = 4096; u.nt = 64; u.i0 = b * TPB + pm * 256; }
        else { const int b = L - 128; u.A = DFTC; u.lda = 512; u.B = PQTC + (size_t)b * 256 * 512; u.ldb = 512; u.nt = 8; u.i0 = b * TPB + LSEQ; }
        return true;
    }
};
struct SchedMerge {
    const bf16_t *MIX, *WB; int g, c;
    __device__ __forceinline__ bool next(int i, GU& u) const {
        const int tile = (i / 3) * g + c, seg = i % 3; if (tile >= 576) return false;
        const int pm = tile >> 2, pn = tile & 3, koff = seg == 0 ? 0 : (seg == 1 ? 512 : 768);
        u.gidx = nullptr; u.lda = DM; u.ldb = DM; u.nt = seg == 0 ? 8 : 4; u.A = MIX + (size_t)pm * BM * DM + koff; u.B = WB + (size_t)pn * BM * DM + koff; u.i0 = pm; u.i1 = pn; u.i2 = seg; u.i3 = 0;
        return true;
    }
};
struct SchedSq {
    const bf16_t *A, *B; int g, c;
    __device__ __forceinline__ bool next(int i, GU& u) const {
        const int L = i * g + c; if (L >= 576) return false;
        const int pm = L >> 2, pn = L & 3;
        u.gidx = nullptr; u.lda = DM; u.ldb = DM; u.nt = 16; u.A = A + (size_t)pm * BM * DM; u.B = B + (size_t)pn * BM * DM; u.i0 = pm; u.i1 = pn; u.i2 = 0; u.i3 = 0;
        return true;
    }
};
struct SchedUp {
    const bf16_t *H, *WGU; const int* IDX; int g, c, nmt;
    __device__ __forceinline__ bool next(int i, GU& u) const {
        const int L = i * g + c; if (L >= NEXP * nmt * 16) return false;
        const int pn = L & 15, mt = (L >> 4) % nmt, e = (L >> 4) / nmt;
        u.A = H; u.gidx = IDX + e * EROWS + mt * 256; u.lda = DM; u.B = WGU + ((size_t)e * 4096 + pn * 256) * DM; u.ldb = DM; u.nt = 16; u.i0 = e * EROWS + mt * 256; u.i1 = pn * 128; u.i2 = 0; u.i3 = 0;
        return true;
    }
};
struct SchedDown {
    const bf16_t *HID, *WDT; int g, c, nmt;
    __device__ __forceinline__ bool next(int i, GU& u) const {
        const int L = i * g + c; if (L >= NEXP * nmt * 4) return false;
        const int pn = L & 3, mt = (L >> 2) % nmt, e = (L >> 2) / nmt;
        u.gidx = nullptr; u.A = HID + (size_t)(e * EROWS + mt * 256) * FF; u.lda = FF; u.B = WDT + ((size_t)e * DM + pn * 256) * FF; u.ldb = FF; u.nt = 32; u.i0 = e * EROWS + mt * 256; u.i1 = pn * 256; u.i2 = 0; u.i3 = 0;
        return true;
    }
};

__device__ __forceinline__ void tr_tile(const float* src, size_t sp, int k0, int n0s, bf16_t* dst, size_t dp, int n0d, LAS float* t) {
    const int tid = threadIdx.x;
#pragma unroll
    for (int q = 0; q < 8; ++q) { const int e = tid + q * NT, i = e >> 6, j = e & 63; t[i * 65 + j] = src[(size_t)(k0 + i) * sp + n0s + j]; }
    __syncthreads();
    { const int j = tid >> 3, i0 = (tid & 7) * 8; u32x4 o;
      o.x = pk2(t[(i0 + 0) * 65 + j], t[(i0 + 1) * 65 + j]); o.y = pk2(t[(i0 + 2) * 65 + j], t[(i0 + 3) * 65 + j]);
      o.z = pk2(t[(i0 + 4) * 65 + j], t[(i0 + 5) * 65 + j]); o.w = pk2(t[(i0 + 6) * 65 + j], t[(i0 + 7) * 65 + j]);
      *(u32x4*)(dst + (size_t)(n0d + j) * dp + k0 + i0) = o; }
    __syncthreads();
}

template <int PART> __device__ __forceinline__ void ph_pre1(const Prm& p, LAS unsigned char* lds) {
    const int tid = threadIdx.x, G = gridDim.x, B = blockIdx.x;
    unsigned char* ws = p.ws;
    if constexpr (PART < 0 || PART == 0) {
        LAS float* sc = (LAS float*)lds; LAS float* red = sc + 17 * 1024;
        float* modv = (float*)(ws + O_MODV);
        bool loaded = false;
        for (int u = B; u < 96; u += G) {
            if (!loaded) { for (int i = tid; i < 17 * 1024; i += NT) { const int r = i >> 10, k = i & 1023; const float v = r < 16 ? p.c[r * 1024 + k] : p.c_ctx[k]; sc[i] = v / (1.0f + expf(-v)); } __syncthreads(); loaded = true; }
            const int l = u / 24, nb = u % 24, cl = tid & 255, col = nb * 256 + cl, kh = tid >> 8;
            float acc[17];
#pragma unroll
            for (int r = 0; r < 17; ++r) acc[r] = 0.f;
            const float* w = p.w_mod + (size_t)l * 1024 * 6144 + col;
            for (int k = kh * 512; k < kh * 512 + 512; ++k) { const float wv = w[(size_t)k * 6144];
#pragma unroll
                for (int r = 0; r < 17; ++r) acc[r] += sc[r * 1024 + k] * wv; }
            if (kh == 1) {
#pragma unroll
                for (int r = 0; r < 17; ++r) red[cl * 17 + r] = acc[r]; }
            __syncthreads();
            if (kh == 0) { const float bb = p.b_mod[l * 6144 + col];
#pragma unroll
                for (int r = 0; r < 17; ++r) modv[((size_t)l * 17 + r) * 6144 + col] = acc[r] + red[cl * 17 + r] + bb; }
            __syncthreads();
        }
        __syncthreads();
    }
    if constexpr (PART < 0 || PART == 1) {
        LAS float* t = (LAS float*)lds;
        constexpr int PER_L = 192 + 768 + 192 + 256 + 256 + 3 * 8192;
        for (int job = B; job < NLAYER * PER_L; job += G) {
            const int l = job / PER_L; int j = job % PER_L;
            const float* win = p.w_in + (size_t)l * DM * INW;
            bf16_t* winm = (bf16_t*)(ws + O_WINM) + (size_t)l * PMW * DM; bf16_t* wins = (bf16_t*)(ws + O_WINS) + (size_t)l * SWR * DM;
            if (j < 192) { const int nt = j / 16, kt = j % 16; tr_tile(win, INW, kt * 64, nt * 64, winm, DM, nt * 64, t); continue; } j -= 192;
            if (j < 768) { const int nt = j / 16, kt = j % 16; tr_tile(win, INW, kt * 64, OFF_GATE + nt * 64, winm, DM, 768 + nt * 64, t); continue; } j -= 768;
            if (j < 192) { const int nt = j / 16, kt = j % 16; tr_tile(win, INW, kt * 64, OFF_HY + nt * 64, wins, DM, nt * 64, t); continue; } j -= 192;
            if (j < 256) { const int nt = j / 16, kt = j % 16; tr_tile(p.w_branch + (size_t)l * DM * DM, DM, kt * 64, nt * 64, (bf16_t*)(ws + O_WBT) + (size_t)l * DM * DM, DM, nt * 64, t); continue; } j -= 256;
            if (j < 256) { const int nt = j / 16, kt = j % 16; tr_tile(p.w_out + (size_t)l * DM * DM, DM, kt * 64, nt * 64, (bf16_t*)(ws + O_WOT) + (size_t)l * DM * DM, DM, nt * 64, t); continue; } j -= 256;
            if (j < 16384) { const int up = j / 8192; j %= 8192; const int e = j / 512, r = j % 512, nt = r / 16, kt = r % 16;
                const float* src = (up ? p.w_up : p.w_gate) + ((size_t)l * NEXP + e) * DM * FF;
                bf16_t* dst = (bf16_t*)(ws + O_WGU) + ((size_t)l * NEXP + e) * 4096 * DM;
                tr_tile(src, FF, kt * 64, nt * 64, dst, DM, (nt >> 1) * 256 + (nt & 1) * 64 + up * 128, t); continue; } j -= 16384;
            { const int e = j / 512, r = j % 512, nt = r / 32, kt = r % 32;
              tr_tile(p.w_down + ((size_t)l * NEXP + e) * FF * DM, DM, kt * 64, nt * 64, (bf16_t*)(ws + O_WDT) + ((size_t)l * NEXP + e) * DM * FF, FF, nt * 64, t); }
        }
    }
    if constexpr (PART < 0 || PART == 2) {
        LAS float* wt = (LAS float*)lds; LAS float* cs = wt + 64 * 65; LAS float* sn = cs + 64;
        for (int u = B; u < NLAYER * 4 * 16; u += G) {
            const int l = u >> 6, g = (u >> 4) & 3, kb = u & 15;
            __syncthreads();
            if (tid < 64) { float s, c; sincospif((float)tid / 32.0f, &s, &c); cs[tid] = c; sn[tid] = s; }
            const float* win = p.w_in + (size_t)l * DM * INW;
#pragma unroll
            for (int q = 0; q < 8; ++q) { const int e = tid + q * NT, i = e >> 6, j = e & 63; wt[i * 65 + j] = win[(size_t)(kb * 64 + i) * INW + OFF_FN + g * 64 + j]; }
            __syncthreads();
            const int k = tid & 63, jq = tid >> 6; bf16_t* wins = (bf16_t*)(ws + O_WINS) + (size_t)l * SWR * DM;
#pragma unroll 1
            for (int jj = 0; jj < 8; ++jj) { const int j = jq * 8 + jj; float P = 0.f, Q = 0.f;
#pragma unroll 4
                for (int c = 0; c < 64; ++c) { const float w = wt[k * 65 + c]; const int m = (c * j) & 63; P += w * cs[m]; Q += w * sn[m]; }
                wins[(size_t)(768 + g * 64 + j) * DM + kb * 64 + k] = (bf16_t)f2bf(P); wins[(size_t)(1024 + g * 64 + j) * DM + kb * 64 + k] = (bf16_t)f2bf(Q); }
        }
        __syncthreads();
    }
    if constexpr (PART < 0 || PART == 3) {
        LAS float* feats = (LAS float*)lds; LAS float* h1 = feats + 32 * 33; LAS float* h2 = h1 + 32 * 64; LAS float* tpos = h2 + 32 * 64;
        float* hraw = (float*)(ws + O_HRAW);
        for (int u = B; u < NLAYER * 72; u += G) {
            const int l = u / 72, pb = u % 72; const bool lat = pb < 64; const int n = lat ? LSEQ : LCTX, p0 = lat ? pb * 32 : (pb - 64) * 32;
            __syncthreads();
            for (int e = tid; e < 32 * 33; e += NT) { const int pp = e / 33, i = e % 33; const int pos = p0 + pp; float v;
                const float tt = (float)pos / (float)(n - 1);
                if (i == 0) { v = tt; tpos[pp] = tt; }
                else { const int bi = (i - 1) & 15; const double band = 1e-4 + (double)bi * ((15.0 - 1e-4) / 15.0); const float xpi = (float)((2.0 / (double)n) * (double)pos * band); float sn_, cs_; sincospif(xpi, &sn_, &cs_);
                       v = (i <= 16) ? cs_ : -sn_; }
                feats[e] = v; }
            __syncthreads();
            const float* w1 = p.hy_w1 + (size_t)l * 33 * 64; const float* w2 = p.hy_w2 + (size_t)l * 64 * 64; const float* w3 = p.hy_w3 + (size_t)l * 64 * 1024;
            { const int j = tid & 63; const float fq_ = p.hy_freq[l * 64 + j], bb = p.hy_b1[l * 64 + j];
#pragma unroll 1
              for (int k = 0; k < 4; ++k) { const int pp = (tid >> 6) + 8 * k; float s = bb;
#pragma unroll 3
                  for (int i = 0; i < 33; ++i) s += feats[pp * 33 + i] * w1[i * 64 + j]; h1[pp * 64 + j] = sinf(fq_ * s); } }
            __syncthreads();
            { const int j = tid & 63; const float fq_ = p.hy_freq[l * 64 + j], bb = p.hy_b2[l * 64 + j];
#pragma unroll 1
              for (int k = 0; k < 4; ++k) { const int pp = (tid >> 6) + 8 * k; float s = bb;
#pragma unroll 4
                  for (int i = 0; i < 64; ++i) s += h1[pp * 64 + i] * w2[i * 64 + j]; h2[pp * 64 + j] = sinf(fq_ * s); } }
            __syncthreads();
#pragma unroll 1
            for (int half = 0; half < 2; ++half) {
                const int col = tid + half * 512; float acc[32];
#pragma unroll
                for (int pp = 0; pp < 32; ++pp) acc[pp] = 0.f;
#pragma unroll 2
                for (int i = 0; i < 64; ++i) { const float w = w3[i * 1024 + col];
#pragma unroll
                    for (int pp = 0; pp < 32; ++pp) acc[pp] += h2[pp * 64 + i] * w; }
                const int ch = col & 255; const float delta = 3.0701134573253943f + (float)ch * ((15.350567286626972f - 3.0701134573253943f) / 255.0f);
#pragma unroll
                for (int pp = 0; pp < 32; ++pp) hraw[((size_t)l * TPB + (lat ? 0 : LSEQ) + p0 + pp) * 1024 + col] = acc[pp] * expf(-tpos[pp] * delta);
            }
        }
        __syncthreads();
    }
    if constexpr (PART < 0 || PART == 4) {
        bf16_t* dftm = (bf16_t*)(ws + O_DFTM); bf16_t* dftc = (bf16_t*)(ws + O_DFTC); float* rope = (float*)(ws + O_ROPE);
        const size_t gt = (size_t)B * NT + tid, gs = (size_t)G * NT;
        for (size_t e = gt; e < (size_t)LSEQ * 512; e += gs) { const int t = (int)(e >> 9), j0 = (int)(e & 511) * 8; unsigned w[4];
#pragma unroll
            for (int q = 0; q < 4; ++q) { float v[2];
#pragma unroll
                for (int z = 0; z < 2; ++z) { const int j = j0 + 2 * q + z, s = j & 2047, m = (t * s) & 2047; float sn_, cs_; sincospif((float)m / 1024.0f, &sn_, &cs_); v[z] = (j < 2048 ? cs_ : -sn_) * (1.0f / 362.03867196751236f); }
                w[q] = pk2(v[0], v[1]); }
            *(u32x4*)(dftm + (size_t)t * 4096 + j0) = (u32x4){w[0], w[1], w[2], w[3]}; }
        for (size_t e = gt; e < (size_t)LCTX * 64; e += gs) { const int t = (int)(e >> 6), j0 = (int)(e & 63) * 8; unsigned w[4];
#pragma unroll
            for (int q = 0; q < 4; ++q) { float v[2];
#pragma unroll
                for (int z = 0; z < 2; ++z) { const int j = j0 + 2 * q + z, s = j & 255, m = (t * s) & 255; float sn_, cs_; sincospif((float)m / 128.0f, &sn_, &cs_); v[z] = (j < 256 ? cs_ : -sn_) * (1.0f / 128.0f); }
                w[q] = pk2(v[0], v[1]); }
            *(u32x4*)(dftc + (size_t)t * 512 + j0) = (u32x4){w[0], w[1], w[2], w[3]}; }
        for (size_t e = gt; e < (size_t)LSEQ * 32; e += gs) { const int t = (int)(e >> 5), j = (int)(e & 31); const int pos = j < 16 ? (t >> 6) : (t & 63); const int ii = j & 15;
            const float inv = powf(10000.0f, -(float)ii / 16.0f); const float ang = (float)pos * inv; rope[e * 2] = cosf(ang); rope[e * 2 + 1] = sinf(ang); }
    }
}

__device__ __forceinline__ void ph_pre2(const Prm& p, LAS unsigned char* lds) {
    const int tid = threadIdx.x, G = gridDim.x, B = blockIdx.x;
    LAS float* red = (LAS float*)lds; LAS float* inv = red + 512; LAS float* tile = inv + 64;
    const float* hraw = (const float*)(p.ws + O_HRAW);
    for (int u = B; u < NLAYER * 2 * 8; u += G) {
        const int l = u >> 4, len = (u >> 3) & 1, ob = u & 7; const int n = len ? LCTX : LSEQ; const int c = tid & 63, ps = tid >> 6, oc = ob * 64 + c;
        const float* hr = hraw + ((size_t)l * TPB + (len ? LSEQ : 0)) * 1024;
        float s = 0.f;
        for (int pp = ps; pp < n; pp += 8) { s += fabsf(hr[(size_t)pp * 1024 + oc]); if (pp >= 1) s += fabsf(hr[(size_t)pp * 1024 + 512 + oc]); }
        __syncthreads();
        red[tid] = s; __syncthreads();
        if (tid < 64) { float a = 0.f; for (int q = 0; q < 8; ++q) a += red[q * 64 + tid]; inv[tid] = 1.0f / a; }
        __syncthreads();
        bf16_t* gbase = len ? (bf16_t*)(p.ws + O_GFC) + ((size_t)l * 512 + ob * 64) * 512 : (bf16_t*)(p.ws + O_GFL) + ((size_t)l * 512 + ob * 64) * 4096;
        const int rowlen = 2 * n;
        for (int pc = 0; pc < n; pc += 64) {
#pragma unroll
            for (int q = 0; q < 16; ++q) { const int e = tid + q * NT, d = e >> 12, pp = (e >> 6) & 63, cc = e & 63; tile[(d * 64 + pp) * 65 + cc] = hr[(size_t)(pc + pp) * 1024 + d * 512 + ob * 64 + cc] * inv[cc]; }
            __syncthreads();
            { const int cc = tid >> 3, q0 = (tid & 7) * 8; bf16_t* grow = gbase + (size_t)cc * rowlen;
              u32x4 o; o.x = pk2(tile[(q0 + 7) * 65 + cc], tile[(q0 + 6) * 65 + cc]); o.y = pk2(tile[(q0 + 5) * 65 + cc], tile[(q0 + 4) * 65 + cc]);
              o.z = pk2(tile[(q0 + 3) * 65 + cc], tile[(q0 + 2) * 65 + cc]); o.w = pk2(tile[(q0 + 1) * 65 + cc], tile[(q0 + 0) * 65 + cc]);
              *(u32x4*)(grow + (n - 8 - pc - q0)) = o;
#pragma unroll
              for (int z = 0; z < 8; ++z) { const int pos = pc + q0 + z; if (pos >= 1) grow[n - 1 + pos] = (bf16_t)f2bf(tile[(64 + q0 + z) * 65 + cc]); }
              if (pc == 0 && q0 == 0) grow[2 * n - 1] = 0; }
            __syncthreads();
        }
    }
}

__device__ __forceinline__ void ph_norm1(const Prm& p, int l) {
    const int lane = threadIdx.x & 63, wv = threadIdx.x >> 6; unsigned char* ws = p.ws;
    float* xs = (float*)(ws + O_XS); bf16_t* H = (bf16_t*)(ws + O_H); const float* modv = (const float*)(ws + O_MODV);
    const bf16_t* Y = (const bf16_t*)(ws + O_Y); const float* aff = (const float*)(ws + O_AFF); const int* sel = (const int*)(ws + O_SEL);
    for (int r = blockIdx.x * 8 + wv; r < NTOK; r += gridDim.x * 8) {
        const int b = r / TPB, t = r % TPB; const bool isctx = t >= LSEQ; const int mrow = isctx ? 16 : b;
        if (l == NLAYER && isctx) continue;
        f32x4 v[4];
        if (l == 0) { const float* src = isctx ? p.ctx + ((size_t)b * LCTX + (t - LSEQ)) * DM : p.x + ((size_t)b * LSEQ + t) * DM;
#pragma unroll
            for (int q = 0; q < 4; ++q) v[q] = *(const f32x4*)(src + q * 256 + lane * 4); }
        else {
#pragma unroll
            for (int q = 0; q < 4; ++q) v[q] = *(const f32x4*)(xs + (size_t)r * DM + q * 256 + lane * 4);
            f32x4 a[4];
#pragma unroll
            for (int q = 0; q < 4; ++q) a[q] = (f32x4){0.f, 0.f, 0.f, 0.f};
            for (int e = 0; e < NEXP; ++e) { const int s = sel[(size_t)r * 16 + e]; if (s < 0) continue; const float w = aff[(size_t)r * 16 + e];
                const bf16_t* yr = Y + ((size_t)e * EROWS + s) * DM;
#pragma unroll
                for (int q = 0; q < 4; ++q) { const u32x2 y2 = *(const u32x2*)(yr + q * 256 + lane * 4); a[q][0] += w * bflo(y2.x); a[q][1] += w * bfhi(y2.x); a[q][2] += w * bflo(y2.y); a[q][3] += w * bfhi(y2.y); } }
            const float* g2 = modv + ((size_t)(l - 1) * 17 + mrow) * 6144 + 5 * 1024;
#pragma unroll
            for (int q = 0; q < 4; ++q) { const f32x4 g = *(const f32x4*)(g2 + q * 256 + lane * 4); v[q] += g * a[q]; }
        }
        float ss = 0.f;
#pragma unroll
        for (int q = 0; q < 4; ++q) ss += v[q][0] * v[q][0] + v[q][1] * v[q][1] + v[q][2] * v[q][2] + v[q][3] * v[q][3];
        ss = wave_sum(ss); const float rstd = rsqrtf(ss * (1.0f / DM) + EPS);
        if (l == NLAYER) {
            float* o = p.out + ((size_t)b * LSEQ + t) * DM;
#pragma unroll
            for (int q = 0; q < 4; ++q) { const f32x4 g = *(const f32x4*)(p.final_g + q * 256 + lane * 4); *(f32x4*)(o + q * 256 + lane * 4) = v[q] * rstd * g; }
        } else {
            const float* ml = modv + ((size_t)l * 17 + mrow) * 6144;
#pragma unroll
            for (int q = 0; q < 4; ++q) { const int c = q * 256 + lane * 4; *(f32x4*)(xs + (size_t)r * DM + c) = v[q];
                const f32x4 g = *(const f32x4*)(p.norm1_g + l * DM + c), sh = *(const f32x4*)(ml + c), sc = *(const f32x4*)(ml + 1024 + c);
                const f32x4 h = (v[q] * rstd * g) * (sc + 1.0f) + sh; u32x2 o; o.x = pk2(h[0], h[1]); o.y = pk2(h[2], h[3]); *(u32x2*)(H + (size_t)r * DM + c) = o; }
        }
    }
}

__device__ __forceinline__ void ph_qkprep(const Prm& p, int l) {
    const int lane = threadIdx.x & 63, wv = threadIdx.x >> 6; unsigned char* ws = p.ws;
    const bf16_t* PM = (const bf16_t*)(ws + O_PM); bf16_t* QP = (bf16_t*)(ws + O_QP); bf16_t* KP = (bf16_t*)(ws + O_KP); const float* rope = (const float*)(ws + O_ROPE);
    const float C2 = 0.125f * 1.4426950408889634f;
    for (int r = blockIdx.x * 8 + wv; r < NTOK; r += gridDim.x * 8) {
        const int t = r % TPB; const bool isctx = t >= LSEQ;
#pragma unroll
        for (int part = 0; part < 2; ++part) {
            if (part == 1 && lane >= 16) break;
            const int c0 = part == 0 ? lane * 8 : 512 + lane * 8;
            const u32x4 raw = *(const u32x4*)(PM + (size_t)r * PMW + c0);
            float v[8]; v[0] = bflo(raw.x); v[1] = bfhi(raw.x); v[2] = bflo(raw.y); v[3] = bfhi(raw.y); v[4] = bflo(raw.z); v[5] = bfhi(raw.z); v[6] = bflo(raw.w); v[7] = bfhi(raw.w);
            float ss = 0.f;
#pragma unroll
            for (int j = 0; j < 8; ++j) ss += v[j] * v[j];
            ss += __shfl_xor(ss, 1); ss += __shfl_xor(ss, 2); ss += __shfl_xor(ss, 4);
            const float rstd = rsqrtf(ss * (1.0f / 64.0f) + EPS);
            const int d0 = (lane & 7) * 8; const float* gn = (part == 0 ? p.q_gain : p.k_gain) + l * 64 + d0;
#pragma unroll
            for (int j = 0; j < 8; ++j) v[j] = v[j] * rstd * gn[j];
            if (!isctx) {
#pragma unroll
                for (int j = 0; j < 4; ++j) { const int pr = (d0 >> 1) + j; const float cs = rope[((size_t)t * 32 + pr) * 2], sn = rope[((size_t)t * 32 + pr) * 2 + 1];
                    const float a = v[2 * j], bq = v[2 * j + 1]; v[2 * j] = a * cs - bq * sn; v[2 * j + 1] = a * sn + bq * cs; }
            }
            const float sc = part == 0 ? C2 : 1.0f;
            u32x4 o; o.x = pk2(v[0] * sc, v[1] * sc); o.y = pk2(v[2] * sc, v[3] * sc); o.z = pk2(v[4] * sc, v[5] * sc); o.w = pk2(v[6] * sc, v[7] * sc);
            if (part == 0) *(u32x4*)(QP + (size_t)r * 512 + lane * 8) = o; else *(u32x4*)(KP + (size_t)r * 128 + lane * 8) = o;
        }
    }
}

__device__ __forceinline__ void ph_attn_naive(const Prm& p, int l, LAS unsigned char* lds) {
    const int tid = threadIdx.x; unsigned char* ws = p.ws;
    const bf16_t* PM = (const bf16_t*)(ws + O_PM); const bf16_t* QP = (const bf16_t*)(ws + O_QP); const bf16_t* KP = (const bf16_t*)(ws + O_KP); bf16_t* MIX = (bf16_t*)(ws + O_MIX);
    LAS float* Ks = (LAS float*)lds; LAS float* Vs = Ks + 32 * 64;
    for (int u = blockIdx.x; u < NBATCH * 2 * 18; u += gridDim.x) {
        const int qc = u % 18, g = (u / 18) & 1, b = u / 36; const bool isctx = qc >= 16;
        if (isctx && l == NLAYER - 1) continue;
        const int qrow = b * TPB + qc * 128 + (tid & 127), hq = g * 4 + (tid >> 7);
        const int k0 = isctx ? LSEQ : 0, nk = isctx ? LCTX : TPB;
        float q[64], o[64];
#pragma unroll
        for (int j = 0; j < 8; ++j) { const u32x4 raw = *(const u32x4*)(QP + (size_t)qrow * 512 + hq * 64 + j * 8);
            q[8 * j] = bflo(raw.x); q[8 * j + 1] = bfhi(raw.x); q[8 * j + 2] = bflo(raw.y); q[8 * j + 3] = bfhi(raw.y); q[8 * j + 4] = bflo(raw.z); q[8 * j + 5] = bfhi(raw.z); q[8 * j + 6] = bflo(raw.w); q[8 * j + 7] = bfhi(raw.w); }
#pragma unroll
        for (int j = 0; j < 64; ++j) o[j] = 0.f;
        float mx = -1e30f, den = 0.f;
        for (int kb = 0; kb < nk; kb += 32) {
            __syncthreads();
            { const int kk = tid >> 4, d4 = (tid & 15) * 4; const size_t krow = (size_t)b * TPB + k0 + kb + kk;
              const u32x2 kr = *(const u32x2*)(KP + krow * 128 + g * 64 + d4); const u32x2 vr = *(const u32x2*)(PM + krow * PMW + 640 + g * 64 + d4);
              *(LAS f32x4*)(Ks + kk * 64 + d4) = (f32x4){bflo(kr.x), bfhi(kr.x), bflo(kr.y), bfhi(kr.y)};
              *(LAS f32x4*)(Vs + kk * 64 + d4) = (f32x4){bflo(vr.x), bfhi(vr.x), bflo(vr.y), bfhi(vr.y)}; }
            __syncthreads();
#pragma unroll 1
            for (int kk = 0; kk < 32; ++kk) {
                float a0 = 0.f, a1 = 0.f;
#pragma unroll
                for (int d4 = 0; d4 < 64; d4 += 8) { const f32x4 kv = *(const LAS f32x4*)(Ks + kk * 64 + d4); const f32x4 kw = *(const LAS f32x4*)(Ks + kk * 64 + d4 + 4);
                    a0 += q[d4] * kv[0] + q[d4 + 1] * kv[1] + q[d4 + 2] * kv[2] + q[d4 + 3] * kv[3]; a1 += q[d4 + 4] * kw[0] + q[d4 + 5] * kw[1] + q[d4 + 6] * kw[2] + q[d4 + 7] * kw[3]; }
                const float a = a0 + a1;
                if (a > mx) { const float sc = exp2f(mx - a); mx = a; den *= sc;
#pragma unroll
                    for (int j = 0; j < 64; ++j) o[j] *= sc; }
                const float pw = exp2f(a - mx); den += pw;
#pragma unroll
                for (int d4 = 0; d4 < 64; d4 += 4) { const f32x4 vv = *(const LAS f32x4*)(Vs + kk * 64 + d4); o[d4] += pw * vv[0]; o[d4 + 1] += pw * vv[1]; o[d4 + 2] += pw * vv[2]; o[d4 + 3] += pw * vv[3]; }
            }
        }
        const float inv = 1.0f / den;
#pragma unroll
        for (int j = 0; j < 8; ++j) { u32x4 w; w.x = pk2(o[8 * j] * inv, o[8 * j + 1] * inv); w.y = pk2(o[8 * j + 2] * inv, o[8 * j + 3] * inv); w.z = pk2(o[8 * j + 4] * inv, o[8 * j + 5] * inv); w.w = pk2(o[8 * j + 6] * inv, o[8 * j + 7] * inv);
            *(u32x4*)(MIX + (size_t)qrow * DM + hq * 64 + j * 8) = w; }
    }
}

template <int N, int TT, int BB, int TP>
__device__ __forceinline__ void hyena_unit(const Prm& p, int l, int ch, LAS unsigned char* lds) {
    const int tid = threadIdx.x; unsigned char* ws = p.ws; constexpr bool LAT = (N == LSEQ);
    const bf16_t* hyt = LAT ? (const bf16_t*)(ws + O_HYT) : (const bf16_t*)(ws + O_HYTC);
    const bf16_t* gf = LAT ? (const bf16_t*)(ws + O_GFL) + (size_t)l * 512 * 4096 : (const bf16_t*)(ws + O_GFC) + (size_t)l * 512 * 512;
    bf16_t* MIX = (bf16_t*)(ws + O_MIX);
    LAS float* Gs = (LAS float*)lds;
    LAS bf16_t* Z0 = (LAS bf16_t*)(lds + 2 * N * 4);
    LAS bf16_t* Z1 = Z0 + N * 16;
    const float* sw = p.hy_sw + (size_t)l * 3 * 768; const float* sb = p.hy_sb + (size_t)l * 768;
    auto sconv = [&](int part, int b, int t) -> float {
        const int c = part * 256 + ch; const bf16_t* row = hyt + ((size_t)c * NBATCH + b) * N;
        float a = sb[c] + sw[768 + c] * bf2f(row[t]);
        if (t > 0) a += sw[c] * bf2f(row[t - 1]);
        if (t < N - 1) a += sw[2 * 768 + c] * bf2f(row[t + 1]);
        return a; };
    __syncthreads();
    for (int e = tid; e < N * 16; e += NT) { const int b = e / N, t = e % N; Z0[t * 16 + b] = (bf16_t)f2bf(sconv(0, b, t)); }
#pragma unroll 1
    for (int order = 0; order < 2; ++order) {
        __syncthreads();
        const bf16_t* grow = gf + ((size_t)order * 256 + ch) * (2 * N);
        for (int e = tid; e < 2 * N; e += NT) Gs[e] = bf2f(grow[e]);
        __syncthreads();
        LAS bf16_t* Zin = order ? Z1 : Z0; LAS bf16_t* Zout = order ? Z0 : Z1;
        const int b0 = (N == LSEQ) ? 0 : (tid >> 8) * 8;
#pragma unroll 1
        for (int tp = 0; tp < TP; ++tp) {
        int tt[TT];
#pragma unroll
        for (int i = 0; i < TT; ++i) tt[i] = LAT ? tid + NT * (tp * TT + i) : (tid & 255);
        float acc[TT][BB];
#pragma unroll
        for (int i = 0; i < TT; ++i)
#pragma unroll
            for (int j = 0; j < BB; ++j) acc[i][j] = 0.f;
#pragma unroll 1
        for (int s = 0; s < N; ++s) {
            float z[BB];
#pragma unroll
            for (int j = 0; j < BB; j += 8) { const u32x4 raw = *(const LAS u32x4*)(Zin + s * 16 + b0 + j);
                z[j] = bflo(raw.x); z[j + 1] = bfhi(raw.x); z[j + 2] = bflo(raw.y); z[j + 3] = bfhi(raw.y); z[j + 4] = bflo(raw.z); z[j + 5] = bfhi(raw.z); z[j + 6] = bflo(raw.w); z[j + 7] = bfhi(raw.w); }
#pragma unroll
            for (int i = 0; i < TT; ++i) { const float gv = Gs[s - tt[i] + N - 1];
#pragma unroll
                for (int j = 0; j < BB; ++j) acc[i][j] += gv * z[j]; }
        }
        const float dskip = p.hy_bias[((size_t)l * 2 + order) * 256 + ch];
#pragma unroll
        for (int i = 0; i < TT; ++i)
#pragma unroll
            for (int j = 0; j < BB; ++j) { const int b = b0 + j, t = tt[i]; const float zin = bf2f(Zin[t * 16 + b]); const float gate = sconv(1 + order, b, t);
                const float y = gate * (acc[i][j] + dskip * zin);
                if (order == 0) Zout[t * 16 + b] = (bf16_t)f2bf(y);
                else MIX[((size_t)b * TPB + (LAT ? 0 : LSEQ) + t) * DM + 512 + ch] = (bf16_t)f2bf(y);
                asm volatile("" ::: "memory"); }
        }
    }
}
__device__ __forceinline__ void ph_hyena_naive(const Prm& p, int l, LAS unsigned char* lds) {
    const int nunits = (l == NLAYER - 1) ? 256 : 512;
    for (int u = blockIdx.x; u < nunits; u += gridDim.x) {
        if (u < 256) hyena_unit<LSEQ, 2, 16, 2>(p, l, u, lds); else hyena_unit<LCTX, 1, 8, 1>(p, l, u - 256, lds);
    }
}

__device__ __forceinline__ void ph_norm2(const Prm& p, int l) {
    const int lane = threadIdx.x & 63, wv = threadIdx.x >> 6; unsigned char* ws = p.ws;
    const float* xs = (const float*)(ws + O_XS); bf16_t* H = (bf16_t*)(ws + O_H); const float* modv = (const float*)(ws + O_MODV); float* aff = (float*)(ws + O_AFF);
    const float* wr = p.w_router + (size_t)l * DM * NEXP;
    for (int r = blockIdx.x * 8 + wv; r < NTOK; r += gridDim.x * 8) {
        const int b = r / TPB, t = r % TPB; const bool isctx = t >= LSEQ; const int mrow = isctx ? 16 : b;
        if (isctx && l == NLAYER - 1) continue;
        f32x4 v[4]; float ss = 0.f;
#pragma unroll
        for (int q = 0; q < 4; ++q) { v[q] = *(const f32x4*)(xs + (size_t)r * DM + q * 256 + lane * 4); ss += v[q][0] * v[q][0] + v[q][1] * v[q][1] + v[q][2] * v[q][2] + v[q][3] * v[q][3]; }
        ss = wave_sum(ss); const float rstd = rsqrtf(ss * (1.0f / DM) + EPS);
        const float* ml = modv + ((size_t)l * 17 + mrow) * 6144;
        float lg[16];
#pragma unroll
        for (int e = 0; e < 16; ++e) lg[e] = 0.f;
#pragma unroll
        for (int q = 0; q < 4; ++q) { const int c = q * 256 + lane * 4;
            const f32x4 g = *(const f32x4*)(p.norm2_g + l * DM + c), sh = *(const f32x4*)(ml + 3 * 1024 + c), sc = *(const f32x4*)(ml + 4 * 1024 + c);
            const f32x4 h = (v[q] * rstd * g) * (sc + 1.0f) + sh; u32x2 o; o.x = pk2(h[0], h[1]); o.y = pk2(h[2], h[3]); *(u32x2*)(H + (size_t)r * DM + c) = o;
#pragma unroll
            for (int j = 0; j < 4; ++j) { const float* wrow = wr + (size_t)(c + j) * 16;
#pragma unroll
                for (int e4 = 0; e4 < 4; ++e4) { const f32x4 w = *(const f32x4*)(wrow + e4 * 4); lg[e4 * 4] += h[j] * w[0]; lg[e4 * 4 + 1] += h[j] * w[1]; lg[e4 * 4 + 2] += h[j] * w[2]; lg[e4 * 4 + 3] += h[j] * w[3]; } } }
        float mxv = -1e30f;
#pragma unroll
        for (int e = 0; e < 16; ++e) { lg[e] = wave_sum(lg[e]); mxv = fmaxf(mxv, lg[e]); }
        float den = 0.f;
#pragma unroll
        for (int e = 0; e < 16; ++e) { lg[e] = expf(lg[e] - mxv); den += lg[e]; }
        const float inv = 1.0f / den; float mine = 0.f;
#pragma unroll
        for (int e = 0; e < 16; ++e) mine = (lane == e) ? lg[e] * inv : mine;
        if (lane < 16) aff[(size_t)r * 16 + lane] = mine;
    }
}

__device__ __forceinline__ void ph_topk(const Prm& p, int l, LAS unsigned char* lds) {
    const int tid = threadIdx.x; unsigned char* ws = p.ws;
    const float* aff = (const float*)(ws + O_AFF); int* sel = (int*)(ws + O_SEL); int* idx = (int*)(ws + O_IDX);
    LAS float* a = (LAS float*)lds;
    const int nunits = (l == NLAYER - 1) ? 256 : 512;
    for (int u = blockIdx.x; u < nunits; u += gridDim.x) {
        const bool isctx = u >= 256; const int b = (u & 255) >> 4, e = u & 15; const int n = isctx ? LCTX : LSEQ, cap = isctx ? CAP_C : CAP_L; const int row0 = b * TPB + (isctx ? LSEQ : 0);
        __syncthreads();
        for (int t = tid; t < n; t += NT) a[t] = aff[(size_t)(row0 + t) * 16 + e];
        __syncthreads();
        for (int t = tid; t < n; t += NT) { const float v = a[t]; int rank = 0;
            for (int j = 0; j < n; j += 4) { const f32x4 w = *(const LAS f32x4*)(a + j);
#pragma unroll
                for (int z = 0; z < 4; ++z) rank += (w[z] > v || (w[z] == v && (j + z) < t)) ? 1 : 0; }
            const int slot = isctx ? (4096 + b * CAP_C + rank) : (b * CAP_L + rank);
            if (rank < cap) { idx[e * EROWS + slot] = row0 + t; sel[(size_t)(row0 + t) * 16 + e] = slot; } else sel[(size_t)(row0 + t) * 16 + e] = -1; }
    }
}

__device__ __forceinline__ void ph_g1(const Prm& p, int l, LAS unsigned char* lds) {
    unsigned char* ws = p.ws; SchedG1 S{(const bf16_t*)(ws + O_H), (const bf16_t*)(ws + O_WINM) + (size_t)l * PMW * DM, (const bf16_t*)(ws + O_WINS) + (size_t)l * SWR * DM, (int)gridDim.x, (int)blockIdx.x};
    struct EpiBoth { EpiPm a; EpiSw b;
        __device__ __forceinline__ void operator()(const f32x4 (&acc)[2][2][4][2], const GU& u, int wr, int wc, int fr, int fq) const { if (u.i2 == 0) a(acc, u, wr, wc, fr, fq); else b(acc, u, wr, wc, fr, fq); } };
    EpiBoth E{EpiPm{(bf16_t*)(ws + O_PM)}, EpiSw{(bf16_t*)(ws + O_HYT), (bf16_t*)(ws + O_HYTC), (bf16_t*)(ws + O_PQT), (bf16_t*)(ws + O_PQTC)}};
    gemm_simple(lds, S, E);
}
__device__ __forceinline__ void ph_fnet(const Prm& p, int l, LAS unsigned char* lds) {
    unsigned char* ws = p.ws; SchedFn S{(const bf16_t*)(ws + O_DFTM), (const bf16_t*)(ws + O_DFTC), (const bf16_t*)(ws + O_PQT), (const bf16_t*)(ws + O_PQTC), (int)gridDim.x, (int)blockIdx.x, (l == NLAYER - 1) ? 0 : 16};
    EpiBf E{(bf16_t*)(ws + O_MIX), DM};
    gemm_simple(lds, S, E);
}
__device__ __forceinline__ void ph_merge(const Prm& p, int l, LAS unsigned char* lds) {
    unsigned char* ws = p.ws; SchedMerge S{(const bf16_t*)(ws + O_MIX), (const bf16_t*)(ws + O_WBT) + (size_t)l * DM * DM, (int)gridDim.x, (int)blockIdx.x};
    EpiMerge E{(const bf16_t*)(ws + O_PM), (float*)(ws + O_Y), (bf16_t*)(ws + O_M)};
    gemm_simple(lds, S, E);
}
__device__ __forceinline__ void ph_wout(const Prm& p, int l, LAS unsigned char* lds) {
    unsigned char* ws = p.ws; SchedSq S{(const bf16_t*)(ws + O_M), (const bf16_t*)(ws + O_WOT) + (size_t)l * DM * DM, (int)gridDim.x, (int)blockIdx.x};
    EpiRes E{(float*)(ws + O_XS), (const float*)(ws + O_MODV) + (size_t)l * 17 * 6144, 2048};
    gemm_simple(lds, S, E);
}
__device__ __forceinline__ void ph_moe_up(const Prm& p, int l, LAS unsigned char* lds) {
    unsigned char* ws = p.ws; SchedUp S{(const bf16_t*)(ws + O_H), (const bf16_t*)(ws + O_WGU) + (size_t)l * NEXP * 4096 * DM, (const int*)(ws + O_IDX), (int)gridDim.x, (int)blockIdx.x, (l == NLAYER - 1) ? 16 : 18};
    EpiGlu E{(bf16_t*)(ws + O_HID)};
    gemm_simple(lds, S, E);
}
__device__ __forceinline__ void ph_moe_down(const Prm& p, int l, LAS unsigned char* lds) {
    unsigned char* ws = p.ws; SchedDown S{(const bf16_t*)(ws + O_HID), (const bf16_t*)(ws + O_WDT) + (size_t)l * NEXP * DM * FF, (int)gridDim.x, (int)blockIdx.x, (l == NLAYER - 1) ? 16 : 18};
    EpiBf E{(bf16_t*)(ws + O_Y), DM};
    gemm_simple(lds, S, E);
}

enum { PH_PRE1A = 100, PH_PRE1B, PH_PRE1C, PH_PRE1D, PH_PRE1E, PH_PRE2 = 1, PH_NORM1, PH_G1, PH_QK, PH_ATTN, PH_HYENA, PH_FNET, PH_MERGE, PH_WOUT, PH_NORM2, PH_TOPK, PH_UP, PH_DOWN };
template <int PH> __global__ void __launch_bounds__(NT, 2) k_ph(Prm p, int l) {
    extern __shared__ __attribute__((aligned(16))) unsigned char shm[];
    LAS unsigned char* lds = (LAS unsigned char*)shm;
    if constexpr (PH == PH_PRE1A) ph_pre1<0>(p, lds);
    if constexpr (PH == PH_PRE1B) ph_pre1<1>(p, lds);
    if constexpr (PH == PH_PRE1C) ph_pre1<2>(p, lds);
    if constexpr (PH == PH_PRE1D) ph_pre1<3>(p, lds);
    if constexpr (PH == PH_PRE1E) ph_pre1<4>(p, lds);
    if constexpr (PH == PH_PRE2) ph_pre2(p, lds);
    if constexpr (PH == PH_NORM1) ph_norm1(p, l);
    if constexpr (PH == PH_G1) ph_g1(p, l, lds);
    if constexpr (PH == PH_QK) ph_qkprep(p, l);
    if constexpr (PH == PH_ATTN) ph_attn_naive(p, l, lds);
    if constexpr (PH == PH_HYENA) ph_hyena_naive(p, l, lds);
    if constexpr (PH == PH_FNET) ph_fnet(p, l, lds);
    if constexpr (PH == PH_MERGE) ph_merge(p, l, lds);
    if constexpr (PH == PH_WOUT) ph_wout(p, l, lds);
    if constexpr (PH == PH_NORM2) ph_norm2(p, l);
    if constexpr (PH == PH_TOPK) ph_topk(p, l, lds);
    if constexpr (PH == PH_UP) ph_moe_up(p, l, lds);
    if constexpr (PH == PH_DOWN) ph_moe_down(p, l, lds);
}
constexpr int LDS_BYTES = 155648;
template <int PH> static void launch(const Prm& p, int l, hipStream_t s) {
    static bool attr = false;
    if (!attr) { (void)hipFuncSetAttribute((const void*)k_ph<PH>, hipFuncAttributeMaxDynamicSharedMemorySize, LDS_BYTES); attr = true; }
    hipLaunchKernelGGL((k_ph<PH>), dim3(256), dim3(NT), LDS_BYTES, s, p, l);
}

extern "C" void kernel_launch(void* const* d_in, const int* in_sizes, int n_in, void* d_out, int out_size, void* d_ws, size_t ws_size, hipStream_t stream) {
    Prm p; memset(&p, 0, sizeof(p));
    const float** f = (const float**)&p;
    for (int i = 0; i < 27; ++i) f[i] = (const float*)d_in[i];
    p.out = (float*)d_out; p.ws = (unsigned char*)d_ws;
    launch<PH_PRE1A>(p, 0, stream); launch<PH_PRE1B>(p, 0, stream); launch<PH_PRE1C>(p, 0, stream); launch<PH_PRE1D>(p, 0, stream); launch<PH_PRE1E>(p, 0, stream);
    launch<PH_PRE2>(p, 0, stream);
    for (int l = 0; l < NLAYER; ++l) {
        launch<PH_NORM1>(p, l, stream);
        launch<PH_G1>(p, l, stream);
        launch<PH_QK>(p, l, stream);
        launch<PH_ATTN>(p, l, stream);
        launch<PH_HYENA>(p, l, stream);
        launch<PH_FNET>(p, l, stream);
        launch<PH_MERGE>(p, l, stream);
        launch<PH_WOUT>(p, l, stream);
        launch<PH_NORM2>(p, l, stream);
        launch<PH_TOPK>(p, l, stream);
        launch<PH_UP>(p, l, stream);
        launch<PH_DOWN>(p, l, stream);
    }
    launch<PH_NORM1>(p, NLAYER, stream);
}
```

```cpp
#include <hip/hip_runtime.h>
#include <stdint.h>
#include <string.h>
#include <hip/hip_bf16.h>
#include <cmath>

#define LAS __attribute__((address_space(3)))
typedef unsigned short bf16_t;
typedef short bf16x8 __attribute__((ext_vector_type(8)));
typedef float f32x4 __attribute__((ext_vector_type(4)));
typedef unsigned u32x4 __attribute__((ext_vector_type(4)));
typedef unsigned u32x2 __attribute__((ext_vector_type(2)));
typedef int i32x4 __attribute__((ext_vector_type(4)));
typedef int i32x8 __attribute__((ext_vector_type(8)));

constexpr int DM = 1024, NBATCH = 16, LSEQ = 2048, LCTX = 256, TPB = 2304, NTOK = 36864, NLAYER = 4;
constexpr int INW = 4864, OFF_HY = 768, OFF_FN = 1536, OFF_GATE = 1792;
constexpr int PMW = 3840;
constexpr int SWR = 1280;
constexpr int NEXP = 16, FF = 2048, CAP_L = 256, CAP_C = 32, EROWS = 4608;
constexpr int NT = 512;
constexpr int LDS_BYTES = 155648;
constexpr float EPS = 1e-6f;

constexpr size_t al256(size_t x) { return (x + 255) & ~(size_t)255; }
constexpr size_t O_BAR   = 0;
constexpr size_t O_QCNT  = 32768;
constexpr size_t O_WINM  = 65536;
constexpr size_t O_WINS  = O_WINM + (size_t)NLAYER * PMW * DM * 2;
constexpr size_t O_WBT   = O_WINS + (size_t)NLAYER * SWR * DM * 2;
constexpr size_t O_WOT   = O_WBT + (size_t)NLAYER * DM * DM * 2;
constexpr size_t O_WGU   = O_WOT + (size_t)NLAYER * DM * DM * 2;
constexpr size_t O_WDT   = O_WGU + (size_t)NLAYER * NEXP * 4096 * DM * 2;
constexpr size_t O_MODV  = O_WDT + (size_t)NLAYER * NEXP * DM * FF * 2;
constexpr size_t O_ROPE  = al256(O_MODV + (size_t)NLAYER * 17 * 6144 * 4);
constexpr size_t O_HRAW  = O_ROPE + (size_t)LSEQ * 32 * 2 * 4;
constexpr size_t O_GFL   = O_HRAW + (size_t)NLAYER * TPB * 1024 * 4;
constexpr size_t O_GFC   = O_GFL + (size_t)NLAYER * 2 * 256 * 4096 * 2;
constexpr size_t O_DFTM  = O_GFC + (size_t)NLAYER * 2 * 256 * 512 * 2;
constexpr size_t O_DFTC  = O_DFTM + (size_t)LSEQ * 4096 * 2;
constexpr size_t O_XS    = O_DFTC + (size_t)LCTX * 512 * 2;
constexpr size_t O_H     = O_XS + (size_t)NTOK * DM * 4;
constexpr size_t O_PM    = O_H + (size_t)NTOK * DM * 2;
constexpr size_t O_HYT   = O_PM + (size_t)NTOK * PMW * 2;
constexpr size_t O_HYTC  = O_HYT + (size_t)768 * NBATCH * LSEQ * 2;
constexpr size_t O_PQT   = O_HYTC + (size_t)768 * NBATCH * LCTX * 2;
constexpr size_t O_PQTC  = O_PQT + (size_t)NBATCH * 256 * 4096 * 2;
constexpr size_t O_QP    = O_PQTC + (size_t)NBATCH * 256 * 512 * 2;
constexpr size_t O_KP    = O_QP + (size_t)NTOK * 512 * 2;
constexpr size_t O_MIX   = O_KP + (size_t)NTOK * 128 * 2;
constexpr size_t O_M     = O_MIX + (size_t)NTOK * DM * 2;
constexpr size_t O_Y     = O_M + (size_t)NTOK * DM * 2;
constexpr size_t O_AFF   = O_Y + (size_t)NTOK * DM * 4;
constexpr size_t O_SEL   = O_AFF + (size_t)NTOK * 16 * 4;
constexpr size_t O_IDX   = O_SEL + (size_t)NTOK * 16 * 4;
constexpr size_t O_END   = O_IDX + (size_t)NEXP * EROWS * 4;
constexpr size_t O_H8G   = O_END;
constexpr size_t O_WG8   = O_H8G + (size_t)NTOK * DM;
constexpr size_t O_END2  = O_WG8 + (size_t)NLAYER * 3072 * DM;
constexpr size_t O_XG8   = O_M;
constexpr size_t O_HID   = O_PM;
static_assert((size_t)NEXP * EROWS * FF * 2 <= O_PQT - O_PM, "hidden alias fits");
static_assert((size_t)NEXP * EROWS * DM * 2 <= (size_t)NTOK * DM * 4, "Y fits in macc region");
static_assert(O_END + (size_t)NTOK * DM + (size_t)NLAYER * 3072 * DM <= (size_t)2147483648ull, "workspace fits 2 GiB");

struct Prm {
    const float *x, *c, *ctx, *c_ctx, *w_mod, *b_mod, *norm1_g, *norm2_g, *w_in, *q_gain, *k_gain, *hy_sw, *hy_sb,
        *hy_w1, *hy_b1, *hy_w2, *hy_b2, *hy_w3, *hy_freq, *hy_bias, *w_branch, *w_out, *w_router, *w_gate, *w_up, *w_down, *final_g;
    float* out;
    unsigned char* ws;
};

__device__ __forceinline__ unsigned f2bf(float f) { unsigned u = __float_as_uint(f); return (u + 0x7fffu + ((u >> 16) & 1u)) >> 16; }
typedef float f32x2_t __attribute__((ext_vector_type(2))); typedef __bf16 bf16x2_t __attribute__((ext_vector_type(2)));
__device__ __forceinline__ unsigned pk2(float lo, float hi) { const f32x2_t v = {lo, hi}; const bf16x2_t b = __builtin_convertvector(v, bf16x2_t); return __builtin_bit_cast(unsigned, b); }
__device__ __forceinline__ float bf2f(bf16_t b) { return __uint_as_float((unsigned)b << 16); }
__device__ __forceinline__ float bflo(unsigned w) { return __uint_as_float(w << 16); }
__device__ __forceinline__ float bfhi(unsigned w) { return __uint_as_float(w & 0xffff0000u); }
__device__ __forceinline__ float clamp8(float x) { return __builtin_amdgcn_fmed3f(x, -448.0f, 448.0f); }
__device__ __forceinline__ unsigned pk4_fp8(float a, float b, float c, float d) { int w = 0; w = __builtin_amdgcn_cvt_pk_fp8_f32(clamp8(a), clamp8(b), w, false); w = __builtin_amdgcn_cvt_pk_fp8_f32(clamp8(c), clamp8(d), w, true); return (unsigned)w; }
constexpr float Y8S = 16.0f, Y8I = 1.0f / 16.0f;
constexpr float W8S = 64.0f, W8I = 1.0f / 64.0f, H8S = 8.0f;
__device__ __forceinline__ float wave_sum(float v) {
#pragma unroll
    for (int o = 32; o >= 1; o >>= 1) v += __shfl_xor(v, o);
    return v;
}
__device__ __forceinline__ float sigmoidf_(float v) { return __builtin_amdgcn_rcpf(1.0f + __expf(-v)); }

__device__ __forceinline__ int tid_() { int t = threadIdx.x; asm volatile("" : "+v"(t)); return t; }
__device__ __forceinline__ int bid_() { int b = blockIdx.x; asm volatile("" : "+s"(b)); return b; }
__device__ __forceinline__ int nblk_() { int g = gridDim.x; asm volatile("" : "+s"(g)); return g; }
constexpr int BM = 256, BK = 64, HALF = 128, HTB = HALF * BK * 2;
__device__ __forceinline__ int lds_byte(int r, int c) { const int st = (r >> 4) * 2 + (c >> 5), rr = r & 15, cc = c & 31, ob = rr * 64 + cc * 2; return st * 1024 + (ob ^ (((ob >> 9) & 1) << 5)); }
__device__ __forceinline__ void stage_rc(int b, int& R, int& C) { const int st = b / 1024, sb = b % 1024, swz = sb ^ (((sb >> 9) & 1) << 5); R = (st >> 1) * 16 + swz / 64; C = (st & 1) * 32 + (swz % 64) / 2; }

struct GU {
    const bf16_t* A;
    const bf16_t* B;
    const int* gidx;
    int lda, ldb, nt;
    int i0, i1, i2, i3;
};

template <class Epi, class Sched>
__device__ __forceinline__ void gemm_simple(LAS unsigned char* lds, const Sched& S, const Epi& E) {
    const int tid = tid_(), wid = tid >> 6, lane = tid & 63, wr = wid >> 2, wc = wid & 3, fr = lane & 15, fq = lane >> 4;
    int R[2], C[2];
#pragma unroll
    for (int i = 0; i < 2; ++i) stage_rc(tid * 16 + i * 8192, R[i], C[i]);
    const int aoff = lds_byte(wr * 64 + fr, fq * 8), boff = lds_byte(wc * 32 + fr, fq * 8);
    GU u;
    for (int ui = 0; S.next(ui, u); ++ui) {
        f32x4 acc[2][2][4][2];
#pragma unroll
        for (int a = 0; a < 2; ++a)
#pragma unroll
            for (int b = 0; b < 2; ++b)
#pragma unroll
                for (int m = 0; m < 4; ++m)
#pragma unroll
                    for (int n = 0; n < 2; ++n) acc[a][b][m][n] = (f32x4){0.f, 0.f, 0.f, 0.f};
        size_t arow[2][2];
#pragma unroll
        for (int h = 0; h < 2; ++h)
#pragma unroll
            for (int i = 0; i < 2; ++i) { const int row = h * HALF + R[i]; arow[h][i] = (size_t)(u.gidx ? u.gidx[row] : row) * u.lda + C[i]; }
        for (int kt = 0; kt < u.nt; ++kt) {
            u32x4 va[2][2], vb[2][2];
#pragma unroll
            for (int h = 0; h < 2; ++h)
#pragma unroll
                for (int i = 0; i < 2; ++i) {
                    va[h][i] = *(const u32x4*)(u.A + arow[h][i] + kt * BK);
                    vb[h][i] = *(const u32x4*)(u.B + (size_t)(h * HALF + R[i]) * u.ldb + C[i] + kt * BK);
                }
            __syncthreads();
#pragma unroll
            for (int h = 0; h < 2; ++h)
#pragma unroll
                for (int i = 0; i < 2; ++i) {
                    *(LAS u32x4*)(lds + h * HTB + tid * 16 + i * 8192) = va[h][i];
                    *(LAS u32x4*)(lds + (2 + h) * HTB + tid * 16 + i * 8192) = vb[h][i];
                }
            __syncthreads();
#pragma unroll
            for (int ai = 0; ai < 2; ++ai) {
                bf16x8 At[4][2];
#pragma unroll
                for (int m = 0; m < 4; ++m)
#pragma unroll
                    for (int k = 0; k < 2; ++k) At[m][k] = *(const LAS bf16x8*)(lds + ai * HTB + aoff + m * 2048 + k * 1024);
#pragma unroll
                for (int bj = 0; bj < 2; ++bj) {
                    bf16x8 Bf[2][2];
#pragma unroll
                    for (int n = 0; n < 2; ++n)
#pragma unroll
                        for (int k = 0; k < 2; ++k) Bf[n][k] = *(const LAS bf16x8*)(lds + (2 + bj) * HTB + boff + n * 2048 + k * 1024);
#pragma unroll
                    for (int m = 0; m < 4; ++m)
#pragma unroll
                        for (int n = 0; n < 2; ++n)
#pragma unroll
                            for (int k = 0; k < 2; ++k)
                                acc[ai][bj][m][n] = __builtin_amdgcn_mfma_f32_16x16x32_bf16(Bf[n][k], At[m][k], acc[ai][bj][m][n], 0, 0, 0);
                }
            }
        }
        E(acc, u, wr, wc, fr, fq);
        __syncthreads();
    }
}


__device__ __forceinline__ int brow_of(int R) { return 64 * (R >> 5) + 16 * ((R >> 2) & 3) + 4 * ((R >> 4) & 1) + (R & 3); }
template <bool GATHER, int MID = 0, bool FP8 = false, class Epi, class Sched>
__device__ __forceinline__ void gemm_fast(LAS unsigned char* lds, const Sched& S, const Epi& E, const int lda, const int ldb, const int nt) {
    const int tid = tid_(), wid = __builtin_amdgcn_readfirstlane(tid >> 6), lane = tid & 63, wr = wid >> 2, wc = wid & 3, fr = lane & 15, fq = lane >> 4;
    int R[2], C[2];
#pragma unroll
    for (int i = 0; i < 2; ++i) stage_rc(tid * 16 + i * 8192, R[i], C[i]);
    unsigned offA[2][2], noffA[2][2], offB[2];
#pragma unroll
    for (int i = 0; i < 2; ++i) { offB[i] = (unsigned)(brow_of(R[i]) * ldb + C[i]) * 2u;
#pragma unroll
        for (int h = 0; h < 2; ++h) { offA[h][i] = (unsigned)((h * HALF + R[i]) * lda + C[i]) * 2u; noffA[h][i] = offA[h][i]; } }
    const size_t kstep = (size_t)(BK * 2);
    const size_t hstepB = (size_t)8 * ldb * 2;
    const size_t hstepA = GATHER ? 0 : (size_t)HALF * lda * 2;
#define OFA1 (GATHER ? offA[1] : offA[0])
#define O2A1 (GATHER ? o2[1] : o2[0])
    const unsigned ldsw = (unsigned)wid * 1024u;
    const int aoff = lds_byte(wr * 64 + fr, fq * 8), boff = lds_byte(wc * 32 + fr, fq * 8);
#define PG8_SA(b, h) (((b) * 2 + (h)) * HTB)
#define PG8_SB(b, h) ((4 + (b) * 2 + (h)) * HTB)
#define PG8_STAGE(bufoff, gbase, voff) do { _Pragma("unroll") for (int _i = 0; _i < 2; ++_i) \
        __builtin_amdgcn_global_load_lds((const unsigned*)((const char*)(gbase) + (voff)[_i]), (LAS unsigned*)(lds + (bufoff) + ldsw + _i * 8192), 16, 0, 0); } while (0)
#define PG8_LDA(dst, b, h) do { _Pragma("unroll") for (int m = 0; m < 4; ++m) _Pragma("unroll") for (int k = 0; k < 2; ++k) dst[m][k] = *(const LAS bf16x8*)(lds + PG8_SA(b, h) + aoff + m * 2048 + k * 1024); } while (0)
#define PG8_LDB(dst, b, h) do { _Pragma("unroll") for (int n = 0; n < 2; ++n) _Pragma("unroll") for (int k = 0; k < 2; ++k) dst[n][k] = *(const LAS bf16x8*)(lds + PG8_SB(b, h) + boff + n * 2048 + k * 1024); } while (0)
#define PG8_CAT(x, y) __builtin_shufflevector(__builtin_bit_cast(i32x4, x), __builtin_bit_cast(i32x4, y), 0, 1, 2, 3, 4, 5, 6, 7)
#define PG8_MMA(ai, bj, At, Bt, Z) do { __builtin_amdgcn_s_setprio(1); _Pragma("unroll") for (int m = 0; m < 4; ++m) _Pragma("unroll") for (int n = 0; n < 2; ++n) { \
        if constexpr (FP8) { const i32x8 bo_ = PG8_CAT(Bt[n][0], Bt[n][1]), ao_ = PG8_CAT(At[m][0], At[m][1]); \
            if (Z) asm volatile("v_mfma_scale_f32_16x16x128_f8f6f4 %0, %1, %2, 0, %3, %3 op_sel_hi:[0,0,0]" : "=&v"(acc[ai][bj][m][n]) : "v"(bo_), "v"(ao_), "v"(one8)); \
            else asm volatile("v_mfma_scale_f32_16x16x128_f8f6f4 %0, %1, %2, %0, %3, %3 op_sel_hi:[0,0,0]" : "+v"(acc[ai][bj][m][n]) : "v"(bo_), "v"(ao_), "v"(one8)); } \
        else { if (Z) acc[ai][bj][m][n] = __builtin_amdgcn_mfma_f32_16x16x32_bf16(Bt[n][0], At[m][0], (f32x4){0.f, 0.f, 0.f, 0.f}, 0, 0, 0); \
               else acc[ai][bj][m][n] = __builtin_amdgcn_mfma_f32_16x16x32_bf16(Bt[n][0], At[m][0], acc[ai][bj][m][n], 0, 0, 0); \
               acc[ai][bj][m][n] = __builtin_amdgcn_mfma_f32_16x16x32_bf16(Bt[n][1], At[m][1], acc[ai][bj][m][n], 0, 0, 0); } } __builtin_amdgcn_s_setprio(0); } while (0)
#define PG8_WAIT_V(n) asm volatile("s_waitcnt vmcnt(" #n ")" ::: "memory")
#define PG8_WAIT_L(n) asm volatile("s_waitcnt lgkmcnt(" #n ")" ::: "memory")
#define PG8_BAR __builtin_amdgcn_s_barrier()
#define PG8_SCHED __builtin_amdgcn_sched_barrier(0)
#define PG8_KITER(t, Z) do { \
            const bool last = (t == nt - 2); \
            if constexpr (MID != 0) { if (t == 8 || t == 12) E.mid(acc, cur, t, wr, wc, fr, fq); } \
            const char* a1 = cA + (size_t)(t + 1) * kstep; \
            const char* a2 = last ? nA : cA + (size_t)(t + 2) * kstep; const char* b2 = last ? nB : cB + (size_t)(t + 2) * kstep; \
            const char* a3 = a2 + kstep; const char* b3 = b2 + kstep; \
            unsigned o2[2][2]; \
_Pragma("unroll") \
            for (int h = 0; h < 2; ++h) \
_Pragma("unroll") \
                for (int i = 0; i < 2; ++i) o2[h][i] = (GATHER && last) ? noffA[h][i] : offA[h][i]; \
            PG8_LDB(B0, 0, 0); PG8_SCHED; PG8_LDA(At, 0, 0); PG8_STAGE(PG8_SA(1, 1), a1 + hstepA, OFA1); \
            PG8_WAIT_L(8); PG8_BAR; PG8_WAIT_L(0); PG8_MMA(0, 0, At, B0, Z); PG8_BAR; PG8_SCHED; \
            PG8_LDB(B1, 0, 1); PG8_STAGE(PG8_SB(0, 0), b2, offB); \
            PG8_BAR; PG8_WAIT_L(0); PG8_MMA(0, 1, At, B1, Z); PG8_BAR; \
            PG8_LDA(At, 0, 1); PG8_STAGE(PG8_SA(0, 0), a2, o2[0]); \
            PG8_BAR; PG8_WAIT_L(0); PG8_MMA(1, 0, At, B0, Z); PG8_BAR; PG8_SCHED; \
            PG8_STAGE(PG8_SB(0, 1), b2 + hstepB, offB); \
            PG8_WAIT_V(6); PG8_BAR; PG8_MMA(1, 1, At, B1, Z); PG8_BAR; \
            PG8_LDB(B0, 1, 0); PG8_SCHED; PG8_LDA(At, 1, 0); PG8_STAGE(PG8_SA(0, 1), a2 + hstepA, O2A1); \
            PG8_WAIT_L(8); PG8_BAR; PG8_WAIT_L(0); PG8_MMA(0, 0, At, B0, 0); PG8_BAR; PG8_SCHED; \
            PG8_LDB(B1, 1, 1); PG8_STAGE(PG8_SB(1, 0), b3, offB); \
            PG8_BAR; PG8_WAIT_L(0); PG8_MMA(0, 1, At, B1, 0); PG8_BAR; \
            PG8_LDA(At, 1, 1); PG8_STAGE(PG8_SA(1, 0), a3, o2[0]); \
            PG8_BAR; PG8_WAIT_L(0); PG8_MMA(1, 0, At, B0, 0); PG8_BAR; PG8_SCHED; \
            PG8_STAGE(PG8_SB(1, 1), b3 + hstepB, offB); \
            PG8_WAIT_V(6); PG8_BAR; PG8_MMA(1, 1, At, B1, 0); PG8_BAR; \
        } while (0)
    GU cur, nxt; int ui = 0;
    if (!S.next(0, cur)) return;
    if (GATHER) {
#pragma unroll
        for (int h = 0; h < 2; ++h)
#pragma unroll
            for (int i = 0; i < 2; ++i) offA[h][i] = (unsigned)(cur.gidx[h * HALF + R[i]] * lda + C[i]) * 2u;
    }
    f32x4 acc[2][2][4][2];
    if constexpr (!FP8) {
#pragma unroll
    for (int a = 0; a < 2; ++a)
#pragma unroll
        for (int b = 0; b < 2; ++b)
#pragma unroll
            for (int m = 0; m < 4; ++m)
#pragma unroll
                for (int n = 0; n < 2; ++n) acc[a][b][m][n] = (f32x4){0.f, 0.f, 0.f, 0.f};
    }
    bf16x8 At[4][2], B0[2][2], B1[2][2];
    const unsigned one8 = 0x7f7f7f7fu;
    const char* cA = (const char*)cur.A; const char* cB = (const char*)cur.B;
    __syncthreads();
    PG8_STAGE(PG8_SB(0, 0), cB, offB); PG8_STAGE(PG8_SA(0, 0), cA, offA[0]); PG8_STAGE(PG8_SB(0, 1), cB + hstepB, offB); PG8_STAGE(PG8_SA(0, 1), cA + hstepA, OFA1);
    if (wr == 1) PG8_BAR;
    PG8_WAIT_V(4); PG8_BAR;
    PG8_STAGE(PG8_SB(1, 0), cB + kstep, offB); PG8_STAGE(PG8_SA(1, 0), cA + kstep, offA[0]); PG8_STAGE(PG8_SB(1, 1), cB + hstepB + kstep, offB);
    PG8_WAIT_V(6); PG8_BAR;
    for (;;) {
        const bool has_next = S.next(ui + 1, nxt);
        const char* nA = has_next ? (const char*)nxt.A : cA; const char* nB = has_next ? (const char*)nxt.B : cB;
        if (GATHER) {
#pragma unroll
            for (int h = 0; h < 2; ++h)
#pragma unroll
                for (int i = 0; i < 2; ++i) noffA[h][i] = has_next ? (unsigned)(nxt.gidx[h * HALF + R[i]] * lda + C[i]) * 2u : offA[h][i];
        }
        if constexpr (FP8) { PG8_KITER(0, 1); for (int t = 2; t < nt; t += 2) PG8_KITER(t, 0); }
        else { for (int t = 0; t < nt; t += 2) PG8_KITER(t, 0); }
        if constexpr (FP8) asm volatile("s_nop 15\n\ts_nop 15" ::: "memory");
        E(acc, cur, wr, wc, fr, fq);
        if (!has_next) break;
        if constexpr (!FP8) {
#pragma unroll
        for (int a = 0; a < 2; ++a)
#pragma unroll
            for (int b = 0; b < 2; ++b)
#pragma unroll
                for (int m = 0; m < 4; ++m)
#pragma unroll
                    for (int n = 0; n < 2; ++n) acc[a][b][m][n] = (f32x4){0.f, 0.f, 0.f, 0.f};
        }
        cur = nxt; cA = nA; cB = nB; ++ui;
        if (GATHER) {
#pragma unroll
            for (int h = 0; h < 2; ++h)
#pragma unroll
                for (int i = 0; i < 2; ++i) offA[h][i] = noffA[h][i];
        }
    }
    PG8_WAIT_V(0);
    if (wr == 0) PG8_BAR;
    PG8_BAR;
#undef OFA1
#undef O2A1
#undef PG8_SA
#undef PG8_SB
#undef PG8_STAGE
#undef PG8_LDA
#undef PG8_LDB
#undef PG8_MMA
#undef PG8_KITER
#undef PG8_CAT
#undef PG8_WAIT_V
#undef PG8_WAIT_L
#undef PG8_BAR
#undef PG8_SCHED
}

#define EPI_ROWS(...)                                                                              \
    _Pragma("unroll") for (int ai = 0; ai < 2; ++ai) _Pragma("unroll") for (int m = 0; m < 4; ++m) { \
        const int row = ai * HALF + wr * 64 + m * 16 + fr; __VA_ARGS__ }
#define EPI_COLS(...) _Pragma("unroll") for (int bj = 0; bj < 2; ++bj) _Pragma("unroll") for (int n = 0; n < 2; ++n) { const int q = bj * 2 + n; const int col = wc * 64 + fq * 16 + bj * 8 + n * 4; __VA_ARGS__ }
#define EPI_PK8(A0, A1) ((u32x4){pk2((A0)[0], (A0)[1]), pk2((A0)[2], (A0)[3]), pk2((A1)[0], (A1)[1]), pk2((A1)[2], (A1)[3])})
__device__ __forceinline__ void unpk8(const u32x4 w, float (&f)[8]) { f[0] = bflo(w.x); f[1] = bfhi(w.x); f[2] = bflo(w.y); f[3] = bfhi(w.y); f[4] = bflo(w.z); f[5] = bfhi(w.z); f[6] = bflo(w.w); f[7] = bfhi(w.w); }

struct EpiPm {
    bf16_t *PM, *QP, *KP; const float *qg, *kg, *rope;
    __device__ __forceinline__ void operator()(const f32x4 (&acc)[2][2][4][2], const GU& u, int wr, int wc, int fr, int fq) const {
        const int r0 = u.i0 * BM, pn = u.i1;
        if (pn == 2 && wc >= 2) {
            bf16_t* ob = PM + (size_t)r0 * PMW + 640 + (wc - 2) * 64; unsigned lo = (unsigned)((wr * 64 + fr) * PMW + 16 * fq); asm volatile("" : "+v"(lo));
            EPI_ROWS({
_Pragma("unroll")
                for (int bj = 0; bj < 2; ++bj) { const f32x4 a0 = acc[ai][bj][m][0] * W8I, a1 = acc[ai][bj][m][1] * W8I; *(u32x4*)(ob + lo + (unsigned)((ai * HALF + m * 16) * PMW) + bj * 8) = EPI_PK8(a0, a1); } })
            return; }
        const bool isq = pn < 2; const float* gn = isq ? qg : kg; const float osc = isq ? 0.125f * 1.4426950408889634f : 1.0f;
        f32x4 g[4];
        EPI_COLS({ g[q] = *(const f32x4*)(gn + 16 * fq + bj * 8 + n * 4) * osc; })
        const int tq = (u.i0 % 9) * 256; const bool isctx = tq >= LSEQ;
        bf16_t* ob = isq ? QP + (size_t)r0 * 512 + (pn * 4 + wc) * 64 + 16 * fq : KP + (size_t)r0 * 128 + wc * 64 + 16 * fq; const int opitch = isq ? 512 : 128;
        EPI_ROWS({ float ss = 0.f;
            EPI_COLS({ const f32x4 v = acc[ai][bj][m][n]; ss += v[0] * v[0] + v[1] * v[1] + v[2] * v[2] + v[3] * v[3]; })
            ss += __shfl_xor(ss, 16); ss += __shfl_xor(ss, 32);
            const float rstd = rsqrtf(ss * (W8I * W8I / 64.0f) + EPS) * W8I;
            f32x4 o[4];
            EPI_COLS({ f32x4 v = acc[ai][bj][m][n] * rstd * g[q];
                if (!isctx) { const f32x4 cs = *(const f32x4*)(rope + ((size_t)(tq + row) * 32 + 8 * fq + 4 * bj + 2 * n) * 2);
                    const float a0 = v[0], b0 = v[1], a1 = v[2], b1 = v[3]; v[0] = a0 * cs[0] - b0 * cs[1]; v[1] = a0 * cs[1] + b0 * cs[0]; v[2] = a1 * cs[2] - b1 * cs[3]; v[3] = a1 * cs[3] + b1 * cs[2]; }
                o[q] = v; })
            *(u32x4*)(ob + (size_t)row * opitch) = EPI_PK8(o[0], o[1]); *(u32x4*)(ob + (size_t)row * opitch + 8) = EPI_PK8(o[2], o[3]); })
    }
};
typedef float f32x2g __attribute__((ext_vector_type(2)));
__device__ __forceinline__ void unpk4_f8(unsigned w, float (&f)[4]) { const f32x2g lo = __builtin_amdgcn_cvt_pk_f32_fp8((int)w, false), hi = __builtin_amdgcn_cvt_pk_f32_fp8((int)w, true); f[0] = lo[0]; f[1] = lo[1]; f[2] = hi[0]; f[3] = hi[1]; }
constexpr int PMG = 768 * 2, PMB = PMW * 2;
struct EpiGate {
    bf16_t* PM;
    __device__ __forceinline__ void operator()(const f32x4 (&acc)[2][2][4][2], const GU& u, int wr, int wc, int fr, int fq) const {
        unsigned char* ob = (unsigned char*)PM + (size_t)(u.i0 * BM) * PMB + PMG + u.i1 * BM; unsigned lo = (unsigned)((wr * 64 + fr) * PMB + wc * 64 + 16 * fq); asm volatile("" : "+v"(lo));
        EPI_ROWS({ unsigned pk[4];
_Pragma("unroll")
            for (int bj = 0; bj < 2; ++bj)
_Pragma("unroll")
                for (int n = 0; n < 2; ++n) { f32x4 w;
_Pragma("unroll")
                    for (int j = 0; j < 4; ++j) w[j] = __builtin_amdgcn_exp2f(acc[ai][bj][m][n][j] * (-1.4426950408889634f * W8I));
                    pk[bj * 2 + n] = pk4_fp8(w[0], w[1], w[2], w[3]); }
            *(u32x4*)(ob + lo + (unsigned)((ai * HALF + m * 16) * PMB)) = (u32x4){pk[0], pk[1], pk[2], pk[3]}; })
    }
};
struct EpiSw {
    bf16_t *HYT, *HYTC, *PQT, *PQTC;
    __device__ __forceinline__ void operator()(const f32x4 (&acc)[2][2][4][2], const GU& u, int wr, int wc, int fr, int fq) const {
        const int pm = u.i0, pn = u.i1, b = pn / 9, j = pn % 9; const bool isctx = (j == 8);
        bf16_t* base; unsigned rs;
        if (pm < 3) { if (isctx) { base = HYTC + ((size_t)pm * 256 * NBATCH + b) * LCTX; rs = NBATCH * LCTX; } else { base = HYT + ((size_t)pm * 256 * NBATCH + b) * LSEQ + j * 256; rs = NBATCH * LSEQ; } }
        else { const int q = pm - 3; if (isctx) { base = PQTC + (size_t)b * 256 * 512 + q * 256; rs = 512; } else { base = PQT + (size_t)b * 256 * 4096 + q * 2048 + j * 256; rs = 4096; } }
        unsigned lo = (unsigned)(wr * 64 + fr) * rs + (unsigned)(wc * 64 + 16 * fq); asm volatile("" : "+v"(lo));
        EPI_ROWS({
_Pragma("unroll")
            for (int bj = 0; bj < 2; ++bj) *(u32x4*)(base + lo + (unsigned)(ai * HALF + m * 16) * rs + bj * 8) = EPI_PK8(acc[ai][bj][m][0], acc[ai][bj][m][1]); })
    }
};
struct EpiBf {
    bf16_t* O; int ld; float scale;
    __device__ __forceinline__ void operator()(const f32x4 (&acc)[2][2][4][2], const GU& u, int wr, int wc, int fr, int fq) const {
        bf16_t* ob = O + (size_t)u.i0 * ld + u.i1; unsigned lo = (unsigned)((wr * 64 + fr) * ld + wc * 64 + 16 * fq); asm volatile("" : "+v"(lo));
        EPI_ROWS({
_Pragma("unroll")
            for (int bj = 0; bj < 2; ++bj) { const f32x4 a0 = acc[ai][bj][m][0] * scale, a1 = acc[ai][bj][m][1] * scale; *(u32x4*)(ob + lo + (unsigned)((ai * HALF + m * 16) * ld) + bj * 8) = EPI_PK8(a0, a1); } })
    }
};
struct EpiF8 {
    unsigned char* O; int ld; float scale;
    __device__ __forceinline__ void operator()(const f32x4 (&acc)[2][2][4][2], const GU& u, int wr, int wc, int fr, int fq) const {
        unsigned char* ob = O + (size_t)u.i0 * ld + u.i1; unsigned lo = (unsigned)((wr * 64 + fr) * ld + wc * 64 + 16 * fq); asm volatile("" : "+v"(lo));
        EPI_ROWS({ unsigned pk[4];
_Pragma("unroll")
            for (int bj = 0; bj < 2; ++bj) { const f32x4 a0 = acc[ai][bj][m][0] * scale, a1 = acc[ai][bj][m][1] * scale;
                pk[bj * 2] = pk4_fp8(a0[0], a0[1], a0[2], a0[3]); pk[bj * 2 + 1] = pk4_fp8(a1[0], a1[1], a1[2], a1[3]); }
            *(u32x4*)(ob + lo + (unsigned)((ai * HALF + m * 16) * ld)) = (u32x4){pk[0], pk[1], pk[2], pk[3]}; })
    }
};
struct EpiMerge {
    const bf16_t* PM; bf16_t* M;
    __device__ __forceinline__ void mid(f32x4 (&acc)[2][2][4][2], const GU& u, int t, int wr, int wc, int fr, int fq) const {
        const unsigned char* gp = (const unsigned char*)PM + (size_t)(u.i0 * BM) * PMB + PMG + ((t == 8) ? 0 : 1024) + u.i1 * BM;
        unsigned lo = (unsigned)((wr * 64 + fr) * PMB + wc * 64 + 16 * fq); asm volatile("" : "+v"(lo));
#pragma unroll
        for (int ai = 0; ai < 2; ++ai) {
            u32x4 ga[4], gb[4];
#pragma unroll
            for (int m = 0; m < 4; ++m) { const unsigned ro = lo + (unsigned)((ai * HALF + m * 16) * PMB); ga[m] = *(const u32x4*)(gp + ro); gb[m] = *(const u32x4*)(gp + ro + 1024); }
#pragma unroll
            for (int m = 0; m < 4; ++m)
#pragma unroll
                for (int bj = 0; bj < 2; ++bj)
#pragma unroll
                    for (int n = 0; n < 2; ++n) { float a[4], b[4]; unpk4_f8(ga[m][bj * 2 + n], a); unpk4_f8(gb[m][bj * 2 + n], b);
                        f32x4 w = acc[ai][bj][m][n];
#pragma unroll
                        for (int j = 0; j < 4; ++j) w[j] *= (1.0f + b[j]) * __builtin_amdgcn_rcpf(1.0f + a[j]);
                        acc[ai][bj][m][n] = w; }
        }
    }
    __device__ __forceinline__ void operator()(const f32x4 (&acc)[2][2][4][2], const GU& u, int wr, int wc, int fr, int fq) const {
        const unsigned char* gp = (const unsigned char*)PM + (size_t)(u.i0 * BM) * PMB + PMG + 2048 + u.i1 * BM; bf16_t* mp = M + (size_t)(u.i0 * BM) * DM + u.i1 * BM;
        unsigned lo = (unsigned)((wr * 64 + fr) * PMB + wc * 64 + 16 * fq), mo = (unsigned)((wr * 64 + fr) * DM + wc * 64 + 16 * fq); asm volatile("" : "+v"(lo), "+v"(mo));
#pragma unroll
        for (int ai = 0; ai < 2; ++ai) {
            u32x4 g[4];
#pragma unroll
            for (int m = 0; m < 4; ++m) g[m] = *(const u32x4*)(gp + lo + (unsigned)((ai * HALF + m * 16) * PMB));
#pragma unroll
            for (int m = 0; m < 4; ++m)
#pragma unroll
                for (int bj = 0; bj < 2; ++bj) { float a0[4], a1[4]; unpk4_f8(g[m][bj * 2], a0); unpk4_f8(g[m][bj * 2 + 1], a1); f32x4 w0 = acc[ai][bj][m][0], w1 = acc[ai][bj][m][1];
#pragma unroll
                    for (int j = 0; j < 4; ++j) { w0[j] *= __builtin_amdgcn_rcpf(1.0f + a0[j]); w1[j] *= __builtin_amdgcn_rcpf(1.0f + a1[j]); }
                    *(u32x4*)(mp + mo + (unsigned)((ai * HALF + m * 16) * DM) + bj * 8) = EPI_PK8(w0, w1); }
        }
    }
};
struct EpiY {
    bf16_t* O;
    __device__ __forceinline__ void operator()(const f32x4 (&acc)[2][2][4][2], const GU& u, int wr, int wc, int fr, int fq) const {
        bf16_t* ob = O + (size_t)(u.i0 * BM) * DM + u.i1 * BM; unsigned lo = (unsigned)((wr * 64 + fr) * DM + wc * 64 + 16 * fq); asm volatile("" : "+v"(lo));
        EPI_ROWS({
_Pragma("unroll")
            for (int bj = 0; bj < 2; ++bj) *(u32x4*)(ob + lo + (unsigned)((ai * HALF + m * 16) * DM) + bj * 8) = EPI_PK8(acc[ai][bj][m][0], acc[ai][bj][m][1]); })
    }
};
struct EpiRes {
    float* XS; const float* modl; int goff;
    __device__ __forceinline__ void operator()(const f32x4 (&acc)[2][2][4][2], const GU& u, int wr, int wc, int fr, int fq) const {
        const int c0 = u.i1 * BM; const int pn9 = u.i0 % 9, b = u.i0 / 9; const int mrow = (pn9 == 8) ? 16 : b;
        const float* gp = modl + (size_t)mrow * 6144 + goff + c0; f32x4 g[4];
        EPI_COLS({ g[q] = *(const f32x4*)(gp + col); })
        float* xb = XS + (size_t)(u.i0 * BM) * DM + c0; unsigned xo = (unsigned)((wr * 64 + fr) * DM + wc * 64 + 16 * fq); asm volatile("" : "+v"(xo));
#pragma unroll
        for (int ai = 0; ai < 2; ++ai) {
            f32x4 o[4][4];
#pragma unroll
            for (int m = 0; m < 4; ++m)
#pragma unroll
                for (int q = 0; q < 4; ++q) o[m][q] = *(const f32x4*)(xb + xo + (unsigned)((ai * HALF + m * 16) * DM) + q * 4);
#pragma unroll
            for (int m = 0; m < 4; ++m)
#pragma unroll
                for (int q = 0; q < 4; ++q) *(f32x4*)(xb + xo + (unsigned)((ai * HALF + m * 16) * DM) + q * 4) = o[m][q] + g[q] * acc[ai][q >> 1][m][q & 1];
        }
    }
};
struct EpiGlu {
    unsigned char* HID;
    __device__ __forceinline__ void operator()(const f32x4 (&acc)[2][2][4][2], const GU& u, int wr, int wc, int fr, int fq) const {
        unsigned char* hb = HID + (size_t)u.i0 * FF + u.i1; unsigned lo = (unsigned)((wr * 64 + fr) * FF + wc * 32 + 8 * fq); asm volatile("" : "+v"(lo));
        EPI_ROWS({ unsigned pk[2];
_Pragma("unroll")
            for (int n = 0; n < 2; ++n) { const f32x4 ga = acc[ai][0][m][n], ua = acc[ai][1][m][n]; f32x4 w;
_Pragma("unroll")
                for (int j = 0; j < 4; ++j) w[j] = (ga[j] * ua[j]) * (W8I * W8I * H8S) * __builtin_amdgcn_rcpf(1.0f + __builtin_amdgcn_exp2f(ga[j] * (-1.4426950408889634f * W8I)));
                pk[n] = pk4_fp8(w[0], w[1], w[2], w[3]); }
            *(u32x2*)(hb + lo + (unsigned)((ai * HALF + m * 16) * FF)) = (u32x2){pk[0], pk[1]}; })
    }
};

__device__ __forceinline__ bool tile_order(int L, int nM, int nN, int& pm, int& pn) {
    const int nwg = nM * nN; if (L >= nwg) return false;
    int wgid = L; { const int q = nwg / 8, r = nwg % 8, xcd = wgid % 8, off = wgid / 8; wgid = (xcd < r ? xcd * (q + 1) : r * (q + 1) + (xcd - r) * q) + off; }
    const int nig = 8 * nN, gid = wgid / nig, fm = gid * 8, gsz = (nM - fm) < 8 ? (nM - fm) : 8;
    pm = fm + ((wgid % nig) % gsz); pn = (wgid % nig) / gsz; return true;
}

struct SchedG1 {
    const bf16_t *H, *WM, *WS; int g, c;
    __device__ __forceinline__ bool next(int i, GU& u) const {
        const int L = i * g + c; if (L >= 144 * 20) return false;
        const int pn_all = L % 20, pmt = L / 20;
        u.gidx = nullptr; u.lda = DM; u.ldb = DM; u.nt = 16; u.i2 = 0; u.i3 = 0;
        if (pn_all < 15) { u.A = H + (size_t)pmt * BM * DM; u.B = WM + (size_t)pn_all * BM * DM; u.i0 = pmt; u.i1 = pn_all; u.i2 = 0; }
        else { u.A = WS + (size_t)(pn_all - 15) * BM * DM; u.B = H + (size_t)pmt * BM * DM; u.i0 = pn_all - 15; u.i1 = pmt; u.i2 = 1; }
        return true;
    }
};
struct SchedFnL {
    const bf16_t *DFTM, *PQT; int g, c;
    __device__ __forceinline__ bool next(int i, GU& u) const {
        const int L = i * g + c; if (L >= 128) return false;
        const int b = L >> 3, pm = L & 7; u.gidx = nullptr; u.i2 = 0; u.i3 = 0; u.i1 = 768; u.lda = 4096; u.ldb = 4096; u.nt = 64;
        u.A = DFTM + (size_t)pm * BM * 4096; u.B = PQT + (size_t)b * 256 * 4096; u.i0 = b * TPB + pm * 256; return true; }
};
struct SchedFnC {
    const bf16_t *DFTC, *PQTC; int g, c;
    __device__ __forceinline__ bool next(int i, GU& u) const {
        const int L = i * g + c; if (L >= 16) return false;
        u.gidx = nullptr; u.i2 = 0; u.i3 = 0; u.i1 = 768; u.lda = 512; u.ldb = 512; u.nt = 8;
        u.A = DFTC; u.B = PQTC + (size_t)L * 256 * 512; u.i0 = L * TPB + LSEQ; return true; }
};
struct SchedSq {
    const bf16_t *A, *B; int g, c, lat, p0, np, rev;
    __device__ __forceinline__ bool next(int i, GU& u) const {
        int pm, pn; if (!tile_order(i * g + (rev ? g - 1 - c : c), np, 4, pm, pn)) return false;
        pm += p0; if (lat) pm = (pm >> 3) * 9 + (pm & 7);
        u.gidx = nullptr; u.lda = DM; u.ldb = DM; u.nt = 16; u.A = A + (size_t)pm * BM * DM; u.B = B + (size_t)pn * BM * DM; u.i0 = pm; u.i1 = pn; u.i2 = 0; u.i3 = 0;
        return true;
    }
};
struct SchedUp {
    const bf16_t *H, *WGU; const int* IDX; int g, c, nmt;
    __device__ __forceinline__ bool next(int i, GU& u) const {
        int rm, pn; if (!tile_order(i * g + c, 16, NEXP * nmt, pn, rm)) return false;
        const int mt = rm % nmt, e = rm / nmt;
        u.A = H + (size_t)(e * EROWS + mt * 256) * 512; u.gidx = nullptr; u.lda = 512; u.B = WGU + ((size_t)e * 4096 + pn * 256) * 512; u.ldb = 512; u.nt = 8; u.i0 = e * EROWS + mt * 256; u.i1 = pn * 128; u.i2 = 0; u.i3 = 0;
        return true;
    }
};
struct SchedDown {
    const bf16_t *HID, *WDT; int g, c, nmt;
    __device__ __forceinline__ bool next(int i, GU& u) const {
        int rm, pn; if (!tile_order(i * g + c, NEXP * nmt, 4, rm, pn)) return false;
        const int mt = rm % nmt, e = rm / nmt;
        u.gidx = nullptr; u.A = HID + (size_t)(e * EROWS + mt * 256) * 1024; u.lda = 1024; u.B = WDT + ((size_t)e * DM + pn * 256) * 1024; u.ldb = 1024; u.nt = 16; u.i0 = e * EROWS + mt * 256; u.i1 = pn * 256; u.i2 = 0; u.i3 = 0;
        return true;
    }
};

__device__ __forceinline__ void tr_tile_w(const float* src, size_t sp, int k0, int n0s, bf16_t* dst, size_t dp, int n0d, LAS float* t, int lane, int split = 0, int f8 = 0) {
    const int r4 = lane >> 4, c4 = lane & 15; f32x4 v[16];
#pragma unroll
    for (int i = 0; i < 16; ++i) v[i] = *(const f32x4*)(src + (size_t)(k0 + 4 * i + r4) * sp + n0s + 4 * c4);
#pragma unroll
    for (int i = 0; i < 16; ++i) {
#pragma unroll
        for (int j = 0; j < 4; ++j) t[(4 * c4 + j) * 65 + 4 * i + r4] = v[i][j]; }
    asm volatile("s_waitcnt lgkmcnt(0)" ::: "memory");
    const int n8 = lane >> 3, k8 = (lane & 7) * 8;
#pragma unroll
    for (int ps = 0; ps < 8; ++ps) { const int n = ps * 8 + n8; const LAS float* r = t + n * 65 + k8;
        if (f8) { u32x2 o; o.x = pk4_fp8(r[0] * W8S, r[1] * W8S, r[2] * W8S, r[3] * W8S); o.y = pk4_fp8(r[4] * W8S, r[5] * W8S, r[6] * W8S, r[7] * W8S);
            *(u32x2*)((unsigned char*)dst + (size_t)(n0d + (split == 2 ? ((n >> 3) * 16 + (n & 7)) : n)) * dp + k0 + k8) = o; }
        else { u32x4 o; o.x = pk2(r[0], r[1]); o.y = pk2(r[2], r[3]); o.z = pk2(r[4], r[5]); o.w = pk2(r[6], r[7]);
            *(u32x4*)(dst + (size_t)(n0d + n + ((split && n >= 32) ? 96 : 0)) * dp + k0 + k8) = o; } }
    asm volatile("s_waitcnt lgkmcnt(0)" ::: "memory");
}

template <int PART> __device__ __forceinline__ void ph_pre1(const Prm& p, LAS unsigned char* lds) {
    const int tid = tid_(), G = nblk_(), B = bid_();
    unsigned char* ws = p.ws;
    if constexpr (PART < 0 || PART == 0) {
        LAS float* sc = (LAS float*)lds; LAS float* red = sc + 17 * 1024;
        float* modv = (float*)(ws + O_MODV);
        bool loaded = false;
        for (int u = B; u < 96; u += G) {
            if (!loaded) { for (int i = tid; i < 17 * 1024; i += NT) { const int r = i >> 10, k = i & 1023; const float v = r < 16 ? p.c[r * 1024 + k] : p.c_ctx[k]; sc[i] = v / (1.0f + expf(-v)); } __syncthreads(); loaded = true; }
            const int l = u / 24, nb = u % 24, cl = tid & 255, col = nb * 256 + cl, kh = tid >> 8;
            float acc[17];
#pragma unroll
            for (int r = 0; r < 17; ++r) acc[r] = 0.f;
            const float* w = p.w_mod + (size_t)l * 1024 * 6144 + col;
            for (int k = kh * 512; k < kh * 512 + 512; ++k) { const float wv = w[(size_t)k * 6144];
#pragma unroll
                for (int r = 0; r < 17; ++r) acc[r] += sc[r * 1024 + k] * wv; }
            if (kh == 1) {
#pragma unroll
                for (int r = 0; r < 17; ++r) red[cl * 17 + r] = acc[r]; }
            __syncthreads();
            if (kh == 0) { const float bb = p.b_mod[l * 6144 + col];
#pragma unroll
                for (int r = 0; r < 17; ++r) modv[((size_t)l * 17 + r) * 6144 + col] = acc[r] + red[cl * 17 + r] + bb; }
            __syncthreads();
        }
        __syncthreads();
    }
    if constexpr (PART < 0 || PART == 1) {
        const int lane = tid & 63, wv = tid >> 6; LAS float* t = (LAS float*)lds + wv * (64 * 65);
        constexpr int PER_L = 192 + 768 + 192 + 256 + 256 + 3 * 8192;
        __syncthreads();
        unsigned* qc = (unsigned*)(ws + O_QCNT);
        for (;;) {
          int job0 = 0; if (lane == 0) job0 = (int)atomicAdd(qc, 4u); job0 = __builtin_amdgcn_readfirstlane(job0);
          if (job0 >= NLAYER * PER_L) break;
          for (int job = job0; job < job0 + 4; ++job) {
            const int l = job / PER_L; int j = job % PER_L;
            const float* win = p.w_in + (size_t)l * DM * INW;
            bf16_t* winm = (bf16_t*)(ws + O_WINM) + (size_t)l * PMW * DM; bf16_t* wins = (bf16_t*)(ws + O_WINS) + (size_t)l * SWR * DM;
            if (j < 192) { const int nt = j / 16, kt = j % 16; tr_tile_w(win, INW, kt * 64, nt * 64, winm, DM, nt * 64, t, lane, 0, 1); continue; } j -= 192;
            if (j < 768) { const int nt = j / 16, kt = j % 16; tr_tile_w(win, INW, kt * 64, OFF_GATE + nt * 64, (bf16_t*)(ws + O_WG8 + (size_t)l * 3072 * DM), DM, nt * 64, t, lane, 0, 1); continue; } j -= 768;
            if (j < 192) { const int nt = j / 16, kt = j % 16; tr_tile_w(win, INW, kt * 64, OFF_HY + nt * 64, wins, DM, nt * 64, t, lane); continue; } j -= 192;
            if (j < 256) { const int nt = j / 16, kt = j % 16; tr_tile_w(p.w_branch + (size_t)l * DM * DM, DM, kt * 64, nt * 64, (bf16_t*)(ws + O_WBT) + (size_t)l * DM * DM, DM, nt * 64, t, lane); continue; } j -= 256;
            if (j < 256) { const int nt = j / 16, kt = j % 16; tr_tile_w(p.w_out + (size_t)l * DM * DM, DM, kt * 64, nt * 64, (bf16_t*)(ws + O_WOT) + (size_t)l * DM * DM, DM, nt * 64, t, lane); continue; } j -= 256;
            if (j < 16384) { const int up = j / 8192; j %= 8192; const int e = j / 512, r = j % 512, nt = r / 16, kt = r % 16;
                const float* src = (up ? p.w_up : p.w_gate) + ((size_t)l * NEXP + e) * DM * FF;
                bf16_t* dst = (bf16_t*)(ws + O_WGU + ((size_t)l * NEXP + e) * 4096 * DM);
                tr_tile_w(src, FF, kt * 64, nt * 64, dst, DM, nt * 128 + up * 8, t, lane, 2, 1); continue; } j -= 16384;
            { const int e = j / 512, r = j % 512, nt = r / 32, kt = r % 32;
              tr_tile_w(p.w_down + ((size_t)l * NEXP + e) * FF * DM, DM, kt * 64, nt * 64, (bf16_t*)(ws + O_WDT + ((size_t)l * NEXP + e) * DM * FF), FF, nt * 64, t, lane, 0, 1); }
          }
        }
        __syncthreads();
    }
    if constexpr (PART < 0 || PART == 2) {
        LAS float* wt = (LAS float*)lds; LAS float* cs = wt + 64 * 65; LAS float* sn = cs + 64;
        for (int u = B; u < NLAYER * 4 * 16; u += G) {
            const int l = u >> 6, g = (u >> 4) & 3, kb = u & 15;
            __syncthreads();
            if (tid < 64) { float s, c; sincospif((float)tid / 32.0f, &s, &c); cs[tid] = c; sn[tid] = s; }
            const float* win = p.w_in + (size_t)l * DM * INW;
#pragma unroll
            for (int q = 0; q < 8; ++q) { const int e = tid + q * NT, i = e >> 6, j = e & 63; wt[i * 65 + j] = win[(size_t)(kb * 64 + i) * INW + OFF_FN + g * 64 + j]; }
            __syncthreads();
            const int k = tid & 63, jq = tid >> 6; bf16_t* wins = (bf16_t*)(ws + O_WINS) + (size_t)l * SWR * DM;
#pragma unroll 1
            for (int jj = 0; jj < 8; ++jj) { const int j = jq * 8 + jj; float P = 0.f, Q = 0.f;
#pragma unroll 4
                for (int c = 0; c < 64; ++c) { const float w = wt[k * 65 + c]; const int m = (c * j) & 63; P += w * cs[m]; Q += w * sn[m]; }
                wins[(size_t)(768 + g * 64 + j) * DM + kb * 64 + k] = (bf16_t)f2bf(P); wins[(size_t)(1024 + g * 64 + j) * DM + kb * 64 + k] = (bf16_t)f2bf(Q); }
        }
        __syncthreads();
    }
    if constexpr (PART < 0 || PART == 3) {
        LAS float* feats = (LAS float*)lds; LAS float* h1 = feats + 32 * 33; LAS float* h2 = h1 + 32 * 64; LAS float* tpos = h2 + 32 * 64;
        float* hraw = (float*)(ws + O_HRAW);
        for (int u = B; u < NLAYER * 72; u += G) {
            const int l = u / 72, pb = u % 72; const bool lat = pb < 64; const int n = lat ? LSEQ : LCTX, p0 = lat ? pb * 32 : (pb - 64) * 32;
            __syncthreads();
            for (int e = tid; e < 32 * 33; e += NT) { const int pp = e / 33, i = e % 33; const int pos = p0 + pp; float v;
                const float tt = (float)pos / (float)(n - 1);
                if (i == 0) { v = tt; tpos[pp] = tt; }
                else { const int bi = (i - 1) & 15; const double band = 1e-4 + (double)bi * ((15.0 - 1e-4) / 15.0); const float xpi = (float)((2.0 / (double)n) * (double)pos * band); float sn_, cs_; sincospif(xpi, &sn_, &cs_);
                       v = (i <= 16) ? cs_ : -sn_; }
                feats[e] = v; }
            __syncthreads();
            const float* w1 = p.hy_w1 + (size_t)l * 33 * 64; const float* w2 = p.hy_w2 + (size_t)l * 64 * 64; const float* w3 = p.hy_w3 + (size_t)l * 64 * 1024;
            { const int j = tid & 63; const float fq_ = p.hy_freq[l * 64 + j], bb = p.hy_b1[l * 64 + j];
#pragma unroll 1
              for (int k = 0; k < 4; ++k) { const int pp = (tid >> 6) + 8 * k; float s = bb;
#pragma unroll 3
                  for (int i = 0; i < 33; ++i) s += feats[pp * 33 + i] * w1[i * 64 + j]; h1[pp * 64 + j] = sinf(fq_ * s); } }
            __syncthreads();
            { const int j = tid & 63; const float fq_ = p.hy_freq[l * 64 + j], bb = p.hy_b2[l * 64 + j];
#pragma unroll 1
              for (int k = 0; k < 4; ++k) { const int pp = (tid >> 6) + 8 * k; float s = bb;
#pragma unroll 4
                  for (int i = 0; i < 64; ++i) s += h1[pp * 64 + i] * w2[i * 64 + j]; h2[pp * 64 + j] = sinf(fq_ * s); } }
            __syncthreads();
#pragma unroll 1
            for (int half = 0; half < 2; ++half) {
                const int col = tid + half * 512; float acc[32];
#pragma unroll
                for (int pp = 0; pp < 32; ++pp) acc[pp] = 0.f;
#pragma unroll 2
                for (int i = 0; i < 64; ++i) { const float w = w3[i * 1024 + col];
#pragma unroll
                    for (int pp = 0; pp < 32; ++pp) acc[pp] += h2[pp * 64 + i] * w; }
                const int ch = col & 255; const float delta = 3.0701134573253943f + (float)ch * ((15.350567286626972f - 3.0701134573253943f) / 255.0f);
#pragma unroll
                for (int pp = 0; pp < 32; ++pp) hraw[((size_t)l * TPB + (lat ? 0 : LSEQ) + p0 + pp) * 1024 + col] = acc[pp] * expf(-tpos[pp] * delta);
            }
        }
        __syncthreads();
    }
    if constexpr (PART < 0 || PART == 4) {
        bf16_t* dftm = (bf16_t*)(ws + O_DFTM); bf16_t* dftc = (bf16_t*)(ws + O_DFTC); float* rope = (float*)(ws + O_ROPE);
        const size_t gt = (size_t)B * NT + tid, gs = (size_t)G * NT;
        for (size_t e = gt; e < (size_t)LSEQ * 512; e += gs) { const int t = (int)(e >> 9), j0 = (int)(e & 511) * 8; unsigned w[4];
#pragma unroll
            for (int q = 0; q < 4; ++q) { float v[2];
#pragma unroll
                for (int z = 0; z < 2; ++z) { const int j = j0 + 2 * q + z, s = j & 2047, m = (t * s) & 2047; float sn_, cs_; sincospif((float)m / 1024.0f, &sn_, &cs_); v[z] = (j < 2048 ? cs_ : -sn_) * (1.0f / 362.03867196751236f); }
                w[q] = pk2(v[0], v[1]); }
            *(u32x4*)(dftm + (size_t)t * 4096 + j0) = (u32x4){w[0], w[1], w[2], w[3]}; }
        for (size_t e = gt; e < (size_t)LCTX * 64; e += gs) { const int t = (int)(e >> 6), j0 = (int)(e & 63) * 8; unsigned w[4];
#pragma unroll
            for (int q = 0; q < 4; ++q) { float v[2];
#pragma unroll
                for (int z = 0; z < 2; ++z) { const int j = j0 + 2 * q + z, s = j & 255, m = (t * s) & 255; float sn_, cs_; sincospif((float)m / 128.0f, &sn_, &cs_); v[z] = (j < 256 ? cs_ : -sn_) * (1.0f / 128.0f); }
                w[q] = pk2(v[0], v[1]); }
            *(u32x4*)(dftc + (size_t)t * 512 + j0) = (u32x4){w[0], w[1], w[2], w[3]}; }
        for (size_t e = gt; e < (size_t)LSEQ * 32; e += gs) { const int t = (int)(e >> 5), j = (int)(e & 31); const int pos = j < 16 ? (t >> 6) : (t & 63); const int ii = j & 15;
            const float inv = powf(10000.0f, -(float)ii / 16.0f); const float ang = (float)pos * inv; rope[e * 2] = cosf(ang); rope[e * 2 + 1] = sinf(ang); }
    }
}

__device__ __forceinline__ void ph_pre2(const Prm& p, LAS unsigned char* lds) {
    const int tid = tid_(), G = nblk_(), B = bid_();
    LAS float* red = (LAS float*)lds; LAS float* inv = red + 512; LAS float* tile = inv + 64;
    const float* hraw = (const float*)(p.ws + O_HRAW);
    for (int u = B; u < NLAYER * 2 * 8 * 4; u += G) {
        const int qt = u & 3, l = u >> 6, len = (u >> 5) & 1, ob = (u >> 2) & 7; const int n = len ? LCTX : LSEQ; const int c = tid & 63, ps = tid >> 6, oc = ob * 64 + c;
        const float* hr = hraw + ((size_t)l * TPB + (len ? LSEQ : 0)) * 1024;
        float s = 0.f;
        for (int pp0 = ps; pp0 < n; pp0 += 64) { float a[8], bq[8];
#pragma unroll
            for (int z = 0; z < 8; ++z) { const int pp = pp0 + 8 * z; a[z] = hr[(size_t)pp * 1024 + oc]; bq[z] = hr[(size_t)pp * 1024 + 512 + oc]; }
#pragma unroll
            for (int z = 0; z < 8; ++z) { s += fabsf(a[z]); if (pp0 + 8 * z >= 1) s += fabsf(bq[z]); } }
        __syncthreads();
        red[tid] = s; __syncthreads();
        if (tid < 64) { float a = 0.f; for (int q = 0; q < 8; ++q) a += red[q * 64 + tid]; inv[tid] = 1.0f / a; }
        __syncthreads();
        bf16_t* gbase = len ? (bf16_t*)(p.ws + O_GFC) + ((size_t)l * 512 + ob * 64) * 512 : (bf16_t*)(p.ws + O_GFL) + ((size_t)l * 512 + ob * 64) * 4096;
        const int rowlen = 2 * n;
        for (int pc = qt * (n >> 2); pc < (qt + 1) * (n >> 2); pc += 64) {
#pragma unroll
            for (int q = 0; q < 16; ++q) { const int e = tid + q * NT, d = e >> 12, pp = (e >> 6) & 63, cc = e & 63; tile[(d * 64 + pp) * 65 + cc] = hr[(size_t)(pc + pp) * 1024 + d * 512 + ob * 64 + cc] * inv[cc]; }
            __syncthreads();
            { const int cc = tid >> 3, q0 = (tid & 7) * 8; bf16_t* grow = gbase + (size_t)cc * rowlen;
              u32x4 o; o.x = pk2(tile[(q0 + 7) * 65 + cc], tile[(q0 + 6) * 65 + cc]); o.y = pk2(tile[(q0 + 5) * 65 + cc], tile[(q0 + 4) * 65 + cc]);
              o.z = pk2(tile[(q0 + 3) * 65 + cc], tile[(q0 + 2) * 65 + cc]); o.w = pk2(tile[(q0 + 1) * 65 + cc], tile[(q0 + 0) * 65 + cc]);
              *(u32x4*)(grow + (n - 8 - pc - q0)) = o;
#pragma unroll
              for (int z = 0; z < 8; ++z) { const int pos = pc + q0 + z; if (pos >= 1) grow[n - 1 + pos] = (bf16_t)f2bf(tile[(64 + q0 + z) * 65 + cc]); }
              if (pc == 0 && q0 == 0) grow[2 * n - 1] = 0; }
            __syncthreads();
        }
    }
}

typedef float f32x2v __attribute__((ext_vector_type(2)));
__device__ __forceinline__ void ph_norm1(const Prm& p, int l, LAS unsigned char* lds) {
    const int tid = tid_(), lane = tid & 63, wv = tid >> 6; unsigned char* ws = p.ws;
    bf16_t* xs = (bf16_t*)(ws + O_XS); bf16_t* H = (bf16_t*)(ws + O_H); const float* modv = (const float*)(ws + O_MODV);
    const unsigned char* Y = (const unsigned char*)(ws + O_Y); const float* aff = (const float*)(ws + O_AFF); const int* sel = (const int*)(ws + O_SEL);
    LAS float* mv = (LAS float*)lds;
    const bool fin = (l == NLAYER); const int NR = fin ? NBATCH * LSEQ : NTOK;
    const int rpb = (NR + nblk_() - 1) / nblk_(); const int i0 = bid_() * rpb; const int i1 = (i0 + rpb < NR) ? i0 + rpb : NR;
    u32x2 nv[4]; int nsl = -1; float naf = 0.f; const bf16_t* Y16 = (const bf16_t*)(ws + O_MIX);
#define N1_LOADROW(rr) do { _Pragma("unroll") for (int q = 0; q < 4; ++q) nv[q] = *(const u32x2*)(xs + (size_t)(rr) * DM + q * 256 + lane * 4); \
        nsl = sel[(size_t)(rr) * 16 + (lane & 15)]; naf = aff[(size_t)(rr) * 16 + (lane & 15)]; } while (0)
#pragma unroll 1
    for (int s0 = i0; s0 < i1; ) {
        const int b = fin ? s0 / LSEQ : s0 / TPB, t0 = fin ? s0 % LSEQ : s0 % TPB; const bool isctx = t0 >= LSEQ; const int mrow = isctx ? 16 : b;
        const int segend = fin ? (b + 1) * LSEQ : b * TPB + (isctx ? TPB : LSEQ); const int s1 = segend < i1 ? segend : i1;
        const int roff = fin ? b * (TPB - LSEQ) : 0;
        __syncthreads();
#pragma unroll
        for (int k = 0; k < 2; ++k) { const int i = tid + k * NT, which = i >> 8, c = (i & 255) * 4; f32x4 val = (f32x4){0.f, 0.f, 0.f, 0.f};
            if (which < 2) { if (l > 0) val = *(const f32x4*)(modv + ((size_t)(l - 1) * 17 + mrow) * 6144 + (which == 0 ? 2 : 5) * 1024 + c); }
            else if (fin) { if (which == 2) val = *(const f32x4*)(p.final_g + c); }
            else { const float* ml = modv + ((size_t)l * 17 + mrow) * 6144;
                if (which == 2) val = *(const f32x4*)(p.norm1_g + l * DM + c) * (*(const f32x4*)(ml + 1024 + c) + 1.0f); else val = *(const f32x4*)(ml + c); }
            *(LAS f32x4*)(mv + which * 1024 + c) = val; }
        __syncthreads();
        int i = s0 + wv;
        if (l > 0 && i < s1) N1_LOADROW(i + roff);
#pragma unroll 1
        for (; i < s1; i += 8) {
            const int r = i + roff; const int t = fin ? i % LSEQ : i % TPB;
            f32x4 v[4];
            if (l == 0) { const float* src = isctx ? p.ctx + ((size_t)b * LCTX + (t - LSEQ)) * DM : p.x + ((size_t)b * LSEQ + t) * DM;
#pragma unroll
                for (int q = 0; q < 4; ++q) v[q] = *(const f32x4*)(src + q * 256 + lane * 4); }
            else {
                u32x2 ny[4];
#pragma unroll
                for (int q = 0; q < 4; ++q) { v[q] = (f32x4){bflo(nv[q].x), bfhi(nv[q].x), bflo(nv[q].y), bfhi(nv[q].y)}; ny[q] = *(const u32x2*)(Y16 + (size_t)r * DM + q * 256 + lane * 4); }
                f32x4 a[4];
#pragma unroll
                for (int q = 0; q < 4; ++q) a[q] = (f32x4){0.f, 0.f, 0.f, 0.f};
                unsigned em = (unsigned)__ballot(nsl >= 0) & 0xffffu;
#pragma unroll 1
                do {
                    unsigned y[8][4]; float w[8];
#pragma unroll
                    for (int k = 0; k < 8; ++k) {
                        if (em != 0u) { const int e = __builtin_ctz(em); em &= em - 1u;
                            const int se = __builtin_amdgcn_readlane(nsl, e); w[k] = __builtin_bit_cast(float, __builtin_amdgcn_readlane(__builtin_bit_cast(int, naf), e)) * Y8I;
                            const unsigned char* yr = Y + ((size_t)e * EROWS + se) * DM; const unsigned lo4 = (unsigned)lane * 4u;
#pragma unroll
                            for (int q = 0; q < 4; ++q) y[k][q] = *(const unsigned*)(yr + lo4 + q * 256); }
                        else { w[k] = 0.f;
#pragma unroll
                            for (int q = 0; q < 4; ++q) y[k][q] = 0u; } }
#pragma unroll
                    for (int k = 0; k < 8; ++k) {
#pragma unroll
                        for (int q = 0; q < 4; ++q) { const f32x2v lo2 = __builtin_amdgcn_cvt_pk_f32_fp8((int)y[k][q], false), hi2 = __builtin_amdgcn_cvt_pk_f32_fp8((int)y[k][q], true);
                            a[q][0] += w[k] * lo2[0]; a[q][1] += w[k] * lo2[1]; a[q][2] += w[k] * hi2[0]; a[q][3] += w[k] * hi2[1]; }
                        __builtin_amdgcn_sched_barrier(0); }
                    asm volatile("" : "+v"(a[0]), "+v"(a[1]), "+v"(a[2]), "+v"(a[3]) :: "memory");
                } while (em != 0u);
                if (i + 8 < s1) N1_LOADROW(r + 8);
#pragma unroll
                for (int q = 0; q < 4; ++q) { const f32x4 g1 = *(const LAS f32x4*)(mv + q * 256 + lane * 4), g = *(const LAS f32x4*)(mv + 1024 + q * 256 + lane * 4);
                    v[q] += g * a[q]; v[q][0] += g1[0] * bflo(ny[q].x); v[q][1] += g1[1] * bfhi(ny[q].x); v[q][2] += g1[2] * bflo(ny[q].y); v[q][3] += g1[3] * bfhi(ny[q].y); }
            }
            float ss = 0.f;
#pragma unroll
            for (int q = 0; q < 4; ++q) ss += v[q][0] * v[q][0] + v[q][1] * v[q][1] + v[q][2] * v[q][2] + v[q][3] * v[q][3];
            ss = wave_sum(ss); const float rstd = rsqrtf(ss * (1.0f / DM) + EPS);
            if (fin) {
                float* o = p.out + (size_t)i * DM;
#pragma unroll
                for (int q = 0; q < 4; ++q) { const f32x4 g = *(const LAS f32x4*)(mv + 2048 + q * 256 + lane * 4); *(f32x4*)(o + q * 256 + lane * 4) = v[q] * rstd * g; }
            } else {
#pragma unroll
                for (int q = 0; q < 4; ++q) { const int c = q * 256 + lane * 4; { u32x2 xo; xo.x = pk2(v[q][0], v[q][1]); xo.y = pk2(v[q][2], v[q][3]); *(u32x2*)(xs + (size_t)r * DM + c) = xo; }
                    const f32x4 ga = *(const LAS f32x4*)(mv + 2048 + c), sh = *(const LAS f32x4*)(mv + 3072 + c);
                    const f32x4 h = (v[q] * rstd) * ga + sh; u32x2 o; o.x = pk2(h[0], h[1]); o.y = pk2(h[2], h[3]); *(u32x2*)(H + (size_t)r * DM + c) = o;
                    *(unsigned*)(ws + O_H8G + (size_t)r * DM + c) = pk4_fp8(h[0], h[1], h[2], h[3]); }
            }
        }
        s0 = s1;
    }
#undef N1_LOADROW
}

__device__ __forceinline__ void ph_qkprep(const Prm& p, int l) {
    const int tid = tid_(), lane = tid & 63, wv = tid >> 6; unsigned char* ws = p.ws;
    const bf16_t* PM = (const bf16_t*)(ws + O_PM); bf16_t* QP = (bf16_t*)(ws + O_QP); bf16_t* KP = (bf16_t*)(ws + O_KP); const float* rope = (const float*)(ws + O_ROPE);
    const float C2 = 0.125f * 1.4426950408889634f;
    for (int r = bid_() * 8 + wv; r < NTOK; r += nblk_() * 8) {
        const int t = r % TPB; const bool isctx = t >= LSEQ;
#pragma unroll
        for (int part = 0; part < 2; ++part) {
            if (part == 1 && lane >= 16) break;
            const int c0 = part == 0 ? lane * 8 : 512 + lane * 8;
            const u32x4 raw = *(const u32x4*)(PM + (size_t)r * PMW + c0);
            float v[8]; v[0] = bflo(raw.x); v[1] = bfhi(raw.x); v[2] = bflo(raw.y); v[3] = bfhi(raw.y); v[4] = bflo(raw.z); v[5] = bfhi(raw.z); v[6] = bflo(raw.w); v[7] = bfhi(raw.w);
            float ss = 0.f;
#pragma unroll
            for (int j = 0; j < 8; ++j) ss += v[j] * v[j];
            ss += __shfl_xor(ss, 1); ss += __shfl_xor(ss, 2); ss += __shfl_xor(ss, 4);
            const float rstd = rsqrtf(ss * (1.0f / 64.0f) + EPS);
            const int d0 = (lane & 7) * 8; const float* gn = (part == 0 ? p.q_gain : p.k_gain) + l * 64 + d0;
#pragma unroll
            for (int j = 0; j < 8; ++j) v[j] = v[j] * rstd * gn[j];
            if (!isctx) {
#pragma unroll
                for (int j = 0; j < 4; ++j) { const int pr = (d0 >> 1) + j; const float cs = rope[((size_t)t * 32 + pr) * 2], sn = rope[((size_t)t * 32 + pr) * 2 + 1];
                    const float a = v[2 * j], bq = v[2 * j + 1]; v[2 * j] = a * cs - bq * sn; v[2 * j + 1] = a * sn + bq * cs; }
            }
            const float sc = part == 0 ? C2 : 1.0f;
            u32x4 o; o.x = pk2(v[0] * sc, v[1] * sc); o.y = pk2(v[2] * sc, v[3] * sc); o.z = pk2(v[4] * sc, v[5] * sc); o.w = pk2(v[6] * sc, v[7] * sc);
            if (part == 0) *(u32x4*)(QP + (size_t)r * 512 + lane * 8) = o; else *(u32x4*)(KP + (size_t)r * 128 + lane * 8) = o;
        }
    }
}

__device__ __forceinline__ void ph_attn_naive(const Prm& p, int l, LAS unsigned char* lds) {
    const int tid = tid_(); unsigned char* ws = p.ws;
    const bf16_t* PM = (const bf16_t*)(ws + O_PM); const bf16_t* QP = (const bf16_t*)(ws + O_QP); const bf16_t* KP = (const bf16_t*)(ws + O_KP); bf16_t* MIX = (bf16_t*)(ws + O_MIX);
    LAS float* Ks = (LAS float*)lds; LAS float* Vs = Ks + 32 * 64;
    for (int u = bid_(); u < NBATCH * 2 * 18; u += nblk_()) {
        const int qc = u % 18, g = (u / 18) & 1, b = u / 36; const bool isctx = qc >= 16;
        if (isctx && l == NLAYER - 1) continue;
        const int qrow = b * TPB + qc * 128 + (tid & 127), hq = g * 4 + (tid >> 7);
        const int k0 = isctx ? LSEQ : 0, nk = isctx ? LCTX : TPB;
        float q[64], o[64];
#pragma unroll
        for (int j = 0; j < 8; ++j) { const u32x4 raw = *(const u32x4*)(QP + (size_t)qrow * 512 + hq * 64 + j * 8);
            q[8 * j] = bflo(raw.x); q[8 * j + 1] = bfhi(raw.x); q[8 * j + 2] = bflo(raw.y); q[8 * j + 3] = bfhi(raw.y); q[8 * j + 4] = bflo(raw.z); q[8 * j + 5] = bfhi(raw.z); q[8 * j + 6] = bflo(raw.w); q[8 * j + 7] = bfhi(raw.w); }
#pragma unroll
        for (int j = 0; j < 64; ++j) o[j] = 0.f;
        float mx = -1e30f, den = 0.f;
        for (int kb = 0; kb < nk; kb += 32) {
            __syncthreads();
            { const int kk = tid >> 4, d4 = (tid & 15) * 4; const size_t krow = (size_t)b * TPB + k0 + kb + kk;
              const u32x2 kr = *(const u32x2*)(KP + krow * 128 + g * 64 + d4); const u32x2 vr = *(const u32x2*)(PM + krow * PMW + 640 + g * 64 + d4);
              *(LAS f32x4*)(Ks + kk * 64 + d4) = (f32x4){bflo(kr.x), bfhi(kr.x), bflo(kr.y), bfhi(kr.y)};
              *(LAS f32x4*)(Vs + kk * 64 + d4) = (f32x4){bflo(vr.x), bfhi(vr.x), bflo(vr.y), bfhi(vr.y)}; }
            __syncthreads();
#pragma unroll 1
            for (int kk = 0; kk < 32; ++kk) {
                float a0 = 0.f, a1 = 0.f;
#pragma unroll
                for (int d4 = 0; d4 < 64; d4 += 8) { const f32x4 kv = *(const LAS f32x4*)(Ks + kk * 64 + d4); const f32x4 kw = *(const LAS f32x4*)(Ks + kk * 64 + d4 + 4);
                    a0 += q[d4] * kv[0] + q[d4 + 1] * kv[1] + q[d4 + 2] * kv[2] + q[d4 + 3] * kv[3]; a1 += q[d4 + 4] * kw[0] + q[d4 + 5] * kw[1] + q[d4 + 6] * kw[2] + q[d4 + 7] * kw[3]; }
                const float a = a0 + a1;
                if (a > mx) { const float sc = exp2f(mx - a); mx = a; den *= sc;
#pragma unroll
                    for (int j = 0; j < 64; ++j) o[j] *= sc; }
                const float pw = exp2f(a - mx); den += pw;
#pragma unroll
                for (int d4 = 0; d4 < 64; d4 += 4) { const f32x4 vv = *(const LAS f32x4*)(Vs + kk * 64 + d4); o[d4] += pw * vv[0]; o[d4 + 1] += pw * vv[1]; o[d4 + 2] += pw * vv[2]; o[d4 + 3] += pw * vv[3]; }
            }
        }
        const float inv = 1.0f / den;
#pragma unroll
        for (int j = 0; j < 8; ++j) { u32x4 w; w.x = pk2(o[8 * j] * inv, o[8 * j + 1] * inv); w.y = pk2(o[8 * j + 2] * inv, o[8 * j + 3] * inv); w.z = pk2(o[8 * j + 4] * inv, o[8 * j + 5] * inv); w.w = pk2(o[8 * j + 6] * inv, o[8 * j + 7] * inv);
            *(u32x4*)(MIX + (size_t)qrow * DM + hq * 64 + j * 8) = w; }
    }
}

namespace attn_body {
using bf16=__hip_bfloat16;
using bf16x8=__attribute__((ext_vector_type(8)))short;
using s16x4=__attribute__((ext_vector_type(4)))short;
using f32x16=__attribute__((ext_vector_type(16)))float;
using u32x4=__attribute__((ext_vector_type(4)))unsigned;
constexpr int D=64;
constexpr int NW=8,QBLK=32,QB=QBLK*NW,KVBLK=64;
__device__ __forceinline__ int crow(int r,int hi){return (r&3)+8*(r>>2)+4*hi;}
#define SBAR() __builtin_amdgcn_sched_barrier(0)
constexpr int NSLOT=3, SLOTB=8192;
constexpr int LDS_K=0, LDS_V=NSLOT*SLOTB, LDS_WS=2*NSLOT*SLOTB, LDS_OST=LDS_WS+NW*64*4, LDS_BYTES=LDS_OST+NW*4096;
constexpr float C2=0.125f*1.4426950408889634f;
__device__ __forceinline__ void glds16(const void*gsrc,unsigned lds_dst){unsigned keep;
  asm volatile("s_mov_b32 %0, m0\n\ts_mov_b32 m0, %2\n\ts_nop 0\n\tglobal_load_lds_dwordx4 %1, off\n\ts_mov_b32 m0, %0":"=&s"(keep):"v"(gsrc),"s"(lds_dst):"memory");}
__device__ __forceinline__ float max3f(float a,float b,float c){float r;asm("v_max3_f32 %0, %1, %2, %3":"=v"(r):"v"(a),"v"(b),"v"(c));return r;}
__device__ __forceinline__ float max2f(float a,float b){float r;asm("v_max_f32_e32 %0, %1, %2":"=v"(r):"v"(a),"v"(b));return r;}
__device__ __forceinline__ float fadd_s(float a,float b){float r;asm("v_add_f32_e32 %0, %1, %2":"=v"(r):"v"(a),"v"(b));return r;}
__device__ __forceinline__ float fsub_s(float a,float b){float r;asm("v_sub_f32_e32 %0, %1, %2":"=v"(r):"v"(a),"v"(b));return r;}
typedef float f32x2_t __attribute__((ext_vector_type(2))); typedef __bf16 bf16x2_t __attribute__((ext_vector_type(2)));
__device__ __forceinline__ unsigned cvtpk_s(float lo,float hi){f32x2_t v={lo,hi};bf16x2_t b=__builtin_convertvector(v,bf16x2_t);return __builtin_bit_cast(unsigned,b);}
#define WAIT_BAR(N) asm volatile("s_waitcnt vmcnt(" #N ") lgkmcnt(0)\n\ts_barrier":::"memory")

__device__ __forceinline__ void qkt(f32x16&p0,f32x16&p1,const char*Kslot,const bf16x8*qr,const f32x16&negm,int r32,int hi){
  const char*kb=Kslot+hi*1024+r32*16;
  #pragma unroll
  for(int d0=0;d0<4;++d0){
    const bf16x8 b0=*reinterpret_cast<const bf16x8*>(kb+d0*2048);
    const bf16x8 b1=*reinterpret_cast<const bf16x8*>(kb+d0*2048+512);
    if(d0==0){p0=__builtin_amdgcn_mfma_f32_32x32x16_bf16(b0,qr[0],negm,0,0,0);p1=__builtin_amdgcn_mfma_f32_32x32x16_bf16(b1,qr[0],negm,0,0,0);}
    else{p0=__builtin_amdgcn_mfma_f32_32x32x16_bf16(b0,qr[d0],p0,0,0,0);p1=__builtin_amdgcn_mfma_f32_32x32x16_bf16(b1,qr[d0],p1,0,0,0);}}
}
typedef __attribute__((address_space(3))) const char* lds_cptr;
typedef short v4i16_t __attribute__((ext_vector_type(4)));
__device__ __forceinline__ void kload8(bf16x8*kf,lds_cptr kp){
  kf[0]=*(const __attribute__((address_space(3))) bf16x8*)(kp);      kf[1]=*(const __attribute__((address_space(3))) bf16x8*)(kp+512);
  kf[2]=*(const __attribute__((address_space(3))) bf16x8*)(kp+2048); kf[3]=*(const __attribute__((address_space(3))) bf16x8*)(kp+2560);
  kf[4]=*(const __attribute__((address_space(3))) bf16x8*)(kp+4096); kf[5]=*(const __attribute__((address_space(3))) bf16x8*)(kp+4608);
  kf[6]=*(const __attribute__((address_space(3))) bf16x8*)(kp+6144); kf[7]=*(const __attribute__((address_space(3))) bf16x8*)(kp+6656);
}
__device__ __forceinline__ void kload2(bf16x8*kf,lds_cptr kp,int j){ kf[2*j]=*(const __attribute__((address_space(3))) bf16x8*)(kp+j*2048); kf[2*j+1]=*(const __attribute__((address_space(3))) bf16x8*)(kp+j*2048+512); }
__device__ __forceinline__ s16x4 vtr(lds_cptr p){ return __builtin_bit_cast(s16x4,__builtin_amdgcn_ds_read_tr16_b64_v4i16((__attribute__((address_space(3))) v4i16_t*)p)); }
__device__ __forceinline__ float rowmax(const f32x16&p0,const f32x16&p1){
  float a=max3f(p0[0],p0[1],p1[0]),b=max3f(p0[2],p0[3],p1[1]);a=max3f(a,p1[2],p1[3]);
  #pragma unroll
  for(int r=4;r<16;r+=4){a=max3f(a,p0[r],p0[r+1]);b=max3f(b,p0[r+2],p0[r+3]);a=max3f(a,p1[r],p1[r+1]);b=max3f(b,p1[r+2],p1[r+3]);}
  const float m=max2f(a,b);
  auto rr=__builtin_amdgcn_permlane32_swap(__float_as_uint(m),__float_as_uint(m),false,false);
  return max2f(__uint_as_float(rr[0]),__uint_as_float(rr[1]));
}
__device__ __forceinline__ void pv(f32x16*o,int vb,bf16x8 pa0,bf16x8 pa1,bf16x8 pa2,bf16x8 pa3){
  #pragma unroll
  for(int d0=0;d0<2;++d0){s16x4 lo[4],hi[4];
    #pragma unroll
    for(int ks=0;ks<4;++ks){
      asm volatile("ds_read_b64_tr_b16 %0,%1 offset:%c2":"=&v"(lo[ks]):"v"(vb),"i"(d0*4096+ks*1024):"memory");
      asm volatile("ds_read_b64_tr_b16 %0,%1 offset:%c2":"=&v"(hi[ks]):"v"(vb),"i"(d0*4096+ks*1024+512):"memory");}
    asm volatile("s_waitcnt lgkmcnt(0)":::"memory");SBAR();
    #define PK(k) (bf16x8){lo[k][0],lo[k][1],lo[k][2],lo[k][3],hi[k][0],hi[k][1],hi[k][2],hi[k][3]}
    o[d0]=__builtin_amdgcn_mfma_f32_32x32x16_bf16(pa0,PK(0),o[d0],0,0,0);
    o[d0]=__builtin_amdgcn_mfma_f32_32x32x16_bf16(pa1,PK(1),o[d0],0,0,0);
    o[d0]=__builtin_amdgcn_mfma_f32_32x32x16_bf16(pa2,PK(2),o[d0],0,0,0);
    o[d0]=__builtin_amdgcn_mfma_f32_32x32x16_bf16(pa3,PK(3),o[d0],0,0,0);
    #undef PK
  }
}

#ifndef ATTN_STORE16
#define ATTN_STORE16(p,v) (*(u32x4*)(p)=(v))
#endif
template<int THRL,int QPI,int KPI,int VPI,int OPI> __device__ __forceinline__ void attn_unit(const bf16*Qu,const bf16*__restrict__ Kh,const bf16*__restrict__ Vh,bf16*Ou,const int NT,char*shm,const float negc=0.f){
  const int tid=tid_(),lane=tid&63,r32=lane&31,hi=lane>>5; const int wid=__builtin_amdgcn_readfirstlane(tid>>6);
  const bf16*Qw=Qu+(long)(wid*QBLK)*QPI;
  const unsigned lds0=(unsigned)(uintptr_t)shm;
  float*wsf=(float*)(shm+LDS_WS)+wid*64;
  const bf16*ksrc=Kh+(long)lane*KPI+wid*8;
  const bf16*vsrc=Vh+(long)(16*(wid&3)+(lane>>2))*VPI+(wid>>2)*32+(lane&3)*8;
  const unsigned kdst=lds0+LDS_K+wid*1024, vdst=lds0+LDS_V+wid*1024;
  #define DMA_K(t,slot) glds16(ksrc+(long)(t)*KVBLK*KPI,(unsigned)__builtin_amdgcn_readfirstlane(kdst+(slot)))
  #define DMA_V(t,slot) glds16(vsrc+(long)(t)*KVBLK*VPI,(unsigned)__builtin_amdgcn_readfirstlane(vdst+(slot)))
  const int vb0=(int)(lds0+LDS_V)+((lane>>4)&1)*32+(lane&3)*8+(4*hi+((lane&15)>>2))*64;
  const char*Kbase=shm+LDS_K; bf16x8 kf[8];
  const lds_cptr shm3=(lds_cptr)shm; const lds_cptr kp0=shm3+LDS_K+hi*1024+r32*16; const lds_cptr vp0=shm3+LDS_V+((lane>>4)&1)*32+(lane&3)*8+(4*hi+((lane&15)>>2))*64;
  if (wid >= 4) __builtin_amdgcn_s_setprio(1);
  DMA_K(0,0);DMA_V(0,0);DMA_K(1,SLOTB);
  bf16x8 qr[4];
  #pragma unroll
  for(int d0=0;d0<4;++d0)qr[d0]=*reinterpret_cast<const bf16x8*>(&Qw[(long)r32*QPI+d0*16+hi*8]);
  float mhat=0.f,l_reg=0.f;f32x16 o[2];o[0]=f32x16{};o[1]=f32x16{};f32x16 negm=f32x16{}; if constexpr(THRL>=1000){ _Pragma("unroll") for(int r=0;r<16;++r)negm[r]=negc; } asm volatile("":"+v"(negm));
  #define CMASK(P0,P1,t) do{}while(0)
  bool resc=false;
  #define START(P0,P1) do{ resc=false; if constexpr(THRL<1000) \
    { const float rm=rowmax(P0,P1); const float dl=rm; mhat=fadd_s(mhat,dl); \
      _Pragma("unroll") for(int r=0;r<16;++r){P0[r]=fsub_s(P0[r],dl);P1[r]=fsub_s(P1[r],dl);} \
      _Pragma("unroll") for(int r=0;r<16;++r)negm[r]=-mhat; asm volatile("":"+v"(negm)); } \
    _Pragma("unroll") for(int r=0;r<16;++r)P0[r]=__builtin_amdgcn_exp2f(P0[r]); }while(0)
  #define RESC() do{ if(resc){ asm volatile("s_waitcnt lgkmcnt(0)":::"memory"); \
      _Pragma("unroll") for(int d_=0;d_<2;++d_) _Pragma("unroll") for(int r=0;r<16;++r)o[d_][r]*=wsf[crow(r,hi)]; } }while(0)
  f32x16 pA0,pA1,pB0,pB1;
  int sl_prev=0,sl_cur=0,sl_next=SLOTB;
  #define ROT() do{sl_prev=sl_cur;sl_cur=sl_next;sl_next=(sl_next==(NSLOT-1)*SLOTB)?0:sl_next+SLOTB;}while(0)
  DMA_K(2,2*SLOTB);
  WAIT_BAR(3);
  qkt(pA0,pA1,Kbase,qr,negm,r32,hi);asm volatile("s_nop 15\n\ts_nop 7":"+v"(pA0),"+v"(pA1));CMASK(pA0,pA1,0);
  START(pA0,pA1);
  _Pragma("unroll") for(int r=0;r<16;++r)pA1[r]=__builtin_amdgcn_exp2f(pA1[r]);
  WAIT_BAR(0);
  DMA_K(3,0);DMA_V(1,SLOTB);
  ROT();
  kload8(kf,kp0+sl_cur);
  WAIT_BAR(2);
  s16x4 vlo[8],vhi[8]; u32x4 pw0,pw1,pw2,pw3;
  #define PKW(P,B) cvtpk_s(P[B],P[B+1])
  #define PAF(k) __builtin_bit_cast(bf16x8,pw##k)
  #define VFR(i) (bf16x8){vlo[i][0],vlo[i][1],vlo[i][2],vlo[i][3],vhi[i][0],vhi[i][1],vhi[i][2],vhi[i][3]}
  #define PIN(x) asm volatile("":"+v"(x))
  #define MX3(a,b,c) __builtin_fmaxf(__builtin_fmaxf((a),(b)),(c))
  #define GAPA(MF,A0,A1,A2,A3,W0,W1,PW) do{ MF; sacc+=A0; sacc+=A1; sacc+=A2; sacc+=A3; PIN(sacc); W0; W1; PIN(PW); SBAR(); }while(0)
  #define EX(v) __builtin_amdgcn_exp2f(v)
  #define GAPB(MF,X,B) do{ MF; X[B]=EX(X[B]); X[B+1]=EX(X[B+1]); X[B+2]=EX(X[B+2]); X[B+3]=EX(X[B+3]); PIN(X); SBAR(); }while(0)
  #define VRD(i) do{ vlo[i]=vtr(vp_+(((i)>>2)*4096+((i)&3)*1024)); vhi[i]=vtr(vp_+(((i)>>2)*4096+((i)&3)*1024+512)); }while(0)
  #define KRD(G,j) do{ if(G){ kload2(kf,kp0+sl_next,j); SBAR(); } }while(0)
  #define STEP(C0,C1,P0,P1,t,GK,GV,GL) do{ SBAR(); \
    const lds_cptr vp_=vp0+sl_prev; \
    VRD(0); SBAR(); float sacc=(P0[0]+P0[1]); \
    GAPA(C0=__builtin_amdgcn_mfma_f32_32x32x16_bf16(kf[0],qr[0],negm,0,0,0), P0[2],P0[3],P0[4],P0[5],     pw0[0]=PKW(P0,0), pw0[1]=PKW(P0,2), pw0); \
    VRD(4); SBAR(); GAPA(C1=__builtin_amdgcn_mfma_f32_32x32x16_bf16(kf[1],qr[0],negm,0,0,0), P0[6],P0[7],P0[8],P0[9],     pw0[2]=PKW(P0,4), pw0[3]=PKW(P0,6), pw0); \
    VRD(1); SBAR(); GAPA(C0=__builtin_amdgcn_mfma_f32_32x32x16_bf16(kf[2],qr[1],C0,0,0,0),   P0[10],P0[11],P0[12],P0[13], pw1[0]=PKW(P0,8), pw1[1]=PKW(P0,10), pw1); \
    VRD(5); SBAR(); GAPA(C1=__builtin_amdgcn_mfma_f32_32x32x16_bf16(kf[3],qr[1],C1,0,0,0),   P0[14],P0[15],P1[0],P1[1],   pw1[2]=PKW(P0,12),pw1[3]=PKW(P0,14), pw1); \
    VRD(2); SBAR(); GAPA(C0=__builtin_amdgcn_mfma_f32_32x32x16_bf16(kf[4],qr[2],C0,0,0,0),   P1[2],P1[3],P1[4],P1[5],     pw2[0]=PKW(P1,0), pw2[1]=PKW(P1,2), pw2); \
    VRD(6); SBAR(); GAPA(C1=__builtin_amdgcn_mfma_f32_32x32x16_bf16(kf[5],qr[2],C1,0,0,0),   P1[6],P1[7],P1[8],P1[9],     pw2[2]=PKW(P1,4), pw2[3]=PKW(P1,6), pw2); \
    VRD(3); SBAR(); GAPA(C0=__builtin_amdgcn_mfma_f32_32x32x16_bf16(kf[6],qr[3],C0,0,0,0),   P1[10],P1[11],P1[12],P1[13], pw3[0]=PKW(P1,8), pw3[1]=PKW(P1,10), pw3); \
    VRD(7); SBAR(); GAPA(C1=__builtin_amdgcn_mfma_f32_32x32x16_bf16(kf[7],qr[3],C1,0,0,0),   P1[14],P1[15],0.f,0.f,       pw3[2]=PKW(P1,12),pw3[3]=PKW(P1,14), pw3); \
    l_reg+=sacc; \
    if(GK){DMA_K((t)+3,sl_cur);} if(GV){DMA_V((t)+1,sl_next);} \
    CMASK(C0,C1,t); \
    if constexpr(THRL<1000){ float a=MX3(C0[0],C0[1],C1[0]),b=MX3(C0[2],C0[3],C1[1]); a=MX3(a,C1[2],C1[3]); \
      _Pragma("unroll") for(int r=4;r<16;r+=4){a=MX3(a,C0[r],C0[r+1]);b=MX3(b,C0[r+2],C0[r+3]);a=MX3(a,C1[r],C1[r+1]);b=MX3(b,C1[r+2],C1[r+3]);} \
      float rm=__builtin_fmaxf(a,b); { auto rr=__builtin_amdgcn_permlane32_swap(__float_as_uint(rm),__float_as_uint(rm),false,false); rm=__builtin_fmaxf(__uint_as_float(rr[0]),__uint_as_float(rr[1])); } \
      resc=false; \
      if(__builtin_expect(__any(rm>(float)THRL),0)){ const float dl=__builtin_fmaxf(rm,0.f); mhat+=dl; \
        _Pragma("unroll") for(int r=0;r<16;++r){C0[r]-=dl;C1[r]-=dl;} \
        _Pragma("unroll") for(int r=0;r<16;++r)negm[r]=-mhat; asm volatile("":"+v"(negm)); \
        const float f=__builtin_amdgcn_exp2f(-dl); l_reg*=f; if(hi==0)wsf[r32]=f; resc=true; } } \
    SBAR(); \
    GAPB(o[0]=__builtin_amdgcn_mfma_f32_32x32x16_bf16(PAF(0),VFR(0),o[0],0,0,0), C0,0); \
    GAPB(o[1]=__builtin_amdgcn_mfma_f32_32x32x16_bf16(PAF(0),VFR(4),o[1],0,0,0), C0,4); \
    KRD(GL,0); GAPB(o[0]=__builtin_amdgcn_mfma_f32_32x32x16_bf16(PAF(1),VFR(1),o[0],0,0,0), C0,8); \
    KRD(GL,1); GAPB(o[1]=__builtin_amdgcn_mfma_f32_32x32x16_bf16(PAF(1),VFR(5),o[1],0,0,0), C0,12); \
    KRD(GL,2); GAPB(o[0]=__builtin_amdgcn_mfma_f32_32x32x16_bf16(PAF(2),VFR(2),o[0],0,0,0), C1,0); \
    KRD(GL,3); GAPB(o[1]=__builtin_amdgcn_mfma_f32_32x32x16_bf16(PAF(2),VFR(6),o[1],0,0,0), C1,4); \
    GAPB(o[0]=__builtin_amdgcn_mfma_f32_32x32x16_bf16(PAF(3),VFR(3),o[0],0,0,0), C1,8); \
    GAPB(o[1]=__builtin_amdgcn_mfma_f32_32x32x16_bf16(PAF(3),VFR(7),o[1],0,0,0), C1,12); \
    }while(0)
  int t=1;
  #undef CMASK
  #define CMASK(P0,P1,t) do{}while(0)
  for(;t+5<NT;t+=2){
    STEP(pB0,pB1,pA0,pA1,t,true,true,true);     WAIT_BAR(2); RESC(); ROT();
    STEP(pA0,pA1,pB0,pB1,t+1,true,true,true);   WAIT_BAR(2); RESC(); ROT();
  }
  #undef CMASK
  #define CMASK(P0,P1,t) do{}while(0)
  #define ENDW(tt) do{ if((tt)+3<NT){WAIT_BAR(2);} else if((tt)+2<NT){WAIT_BAR(1);} else {WAIT_BAR(0);} }while(0)
  for(;t+1<NT;t+=2){
    STEP(pB0,pB1,pA0,pA1,t,(t+3<NT),(t+1<NT),(t+1<NT));       ENDW(t);   RESC(); ROT();
    STEP(pA0,pA1,pB0,pB1,t+1,(t+4<NT),(t+2<NT),(t+2<NT));     ENDW(t+1); RESC(); ROT();
  }
  STEP(pB0,pB1,pA0,pA1,NT-1,false,false,false); RESC();
  { float sacc=pB0[0]+pB0[1]; _Pragma("unroll") for(int r=2;r<16;++r)sacc+=pB0[r]; _Pragma("unroll") for(int r=0;r<16;++r)sacc+=pB1[r]; l_reg+=sacc;
    pw0=(u32x4){PKW(pB0,0),PKW(pB0,2),PKW(pB0,4),PKW(pB0,6)};pw1=(u32x4){PKW(pB0,8),PKW(pB0,10),PKW(pB0,12),PKW(pB0,14)};pw2=(u32x4){PKW(pB1,0),PKW(pB1,2),PKW(pB1,4),PKW(pB1,6)};pw3=(u32x4){PKW(pB1,8),PKW(pB1,10),PKW(pB1,12),PKW(pB1,14)};
    SBAR(); pv(o,vb0+sl_cur,PAF(0),PAF(1),PAF(2),PAF(3)); }
  #undef PKW
  #undef PAF
  #undef VFR
  #undef PIN
  #undef MX3
  #undef GAPA
  #undef GAPB
  #undef EX
  #undef VRD
  #undef KRD
  #undef STEP
  #undef ENDW
  {auto rr=__builtin_amdgcn_permlane32_swap(__float_as_uint(l_reg),__float_as_uint(l_reg),false,false);l_reg=__uint_as_float(rr[0])+__uint_as_float(rr[1]);}
  if(hi==0)wsf[32+r32]=l_reg;asm volatile("s_waitcnt lgkmcnt(0)":::"memory");
  float rli[16];
  #pragma unroll
  for(int r=0;r<16;++r)rli[r]=__builtin_amdgcn_rcpf(wsf[32+crow(r,hi)]);
  bf16*Ow=Ou+(long)(wid*QBLK)*OPI;
  { bf16*stg=(bf16*)(shm+LDS_OST)+wid*2048;
    #pragma unroll
    for(int r=0;r<16;++r){const int orow=crow(r,hi);
      #pragma unroll
      for(int d0=0;d0<2;++d0)stg[orow*64+d0*32+r32]=__float2bfloat16(o[d0][r]*rli[r]);}
    asm volatile("s_waitcnt lgkmcnt(0)":::"memory");
    #pragma unroll
    for(int i=0;i<4;++i){const int row=i*8+(lane>>3),ch=lane&7; const u32x4 v=*(const u32x4*)(stg+row*64+ch*8); ATTN_STORE16(Ow+(long)row*OPI+ch*8,v);} }
  asm volatile("s_waitcnt lgkmcnt(0)\n\ts_barrier":::"memory");
  __builtin_amdgcn_s_setprio(0);
  #undef DMA_K
  #undef DMA_V
  #undef CMASK
  #undef START
  #undef RESC
  #undef ROT
}
constexpr int ATTN_LDS_BYTES=LDS_BYTES;
#undef SBAR
#undef WAIT_BAR
}

__device__ __forceinline__ void ph_attn(const Prm& p, int l, char* shm) {
    using attn_body::bf16;
    unsigned char* ws = p.ws;
    const bf16* QP = (const bf16*)(ws + O_QP); const bf16* KP = (const bf16*)(ws + O_KP); const bf16* PM = (const bf16*)(ws + O_PM); bf16* MIX = (bf16*)(ws + O_MIX);
    const int nunits = 1024 + ((l == NLAYER - 1) ? 0 : 128);
    for (int L = bid_(); L < nunits; L += nblk_()) {
        int b, h, g, nt; long qrow0, krow0;
        if (L < 1024) { const int i = L >> 8, cc = L & 255, xcd = cc & 7, slot = cc >> 3, id = i * 8 + xcd; b = id >> 1; g = id & 1; h = g * 4 + (slot >> 3); qrow0 = (long)b * TPB + (slot & 7) * 256; krow0 = (long)b * TPB; nt = 36; }
        else { const int j = L - 1024; b = j >> 3; h = j & 7; g = h >> 2; qrow0 = (long)b * TPB + LSEQ; krow0 = qrow0; nt = 4; }
        attn_body::attn_unit<8, 512, 128, PMW, DM>(QP + qrow0 * 512 + h * 64, KP + krow0 * 128 + g * 64, PM + krow0 * PMW + 640 + g * 64, MIX + qrow0 * DM + h * 64, nt, shm);
    }
}

template <int N, int TT, int BB, int TP>
__device__ __forceinline__ void hyena_unit(const Prm& p, int l, int ch, LAS unsigned char* lds) {
    const int tid = tid_(); unsigned char* ws = p.ws; constexpr bool LAT = (N == LSEQ);
    const bf16_t* hyt = LAT ? (const bf16_t*)(ws + O_HYT) : (const bf16_t*)(ws + O_HYTC);
    const bf16_t* gf = LAT ? (const bf16_t*)(ws + O_GFL) + (size_t)l * 512 * 4096 : (const bf16_t*)(ws + O_GFC) + (size_t)l * 512 * 512;
    bf16_t* MIX = (bf16_t*)(ws + O_MIX);
    LAS float* Gs = (LAS float*)lds;
    LAS bf16_t* Z0 = (LAS bf16_t*)(lds + 2 * N * 4);
    LAS bf16_t* Z1 = Z0 + N * 16;
    const float* sw = p.hy_sw + (size_t)l * 3 * 768; const float* sb = p.hy_sb + (size_t)l * 768;
    auto sconv = [&](int part, int b, int t) -> float {
        const int c = part * 256 + ch; const bf16_t* row = hyt + ((size_t)c * NBATCH + b) * N;
        float a = sb[c] + sw[768 + c] * bf2f(row[t]);
        if (t > 0) a += sw[c] * bf2f(row[t - 1]);
        if (t < N - 1) a += sw[2 * 768 + c] * bf2f(row[t + 1]);
        return a; };
    __syncthreads();
    for (int e = tid; e < N * 16; e += NT) { const int b = e / N, t = e % N; Z0[t * 16 + b] = (bf16_t)f2bf(sconv(0, b, t)); }
#pragma unroll 1
    for (int order = 0; order < 2; ++order) {
        __syncthreads();
        const bf16_t* grow = gf + ((size_t)order * 256 + ch) * (2 * N);
        for (int e = tid; e < 2 * N; e += NT) Gs[e] = bf2f(grow[e]);
        __syncthreads();
        LAS bf16_t* Zin = order ? Z1 : Z0; LAS bf16_t* Zout = order ? Z0 : Z1;
        const int b0 = (N == LSEQ) ? 0 : (tid >> 8) * 8;
#pragma unroll 1
        for (int tp = 0; tp < TP; ++tp) {
        int tt[TT];
#pragma unroll
        for (int i = 0; i < TT; ++i) tt[i] = LAT ? tid + NT * (tp * TT + i) : (tid & 255);
        float acc[TT][BB];
#pragma unroll
        for (int i = 0; i < TT; ++i)
#pragma unroll
            for (int j = 0; j < BB; ++j) acc[i][j] = 0.f;
#pragma unroll 1
        for (int s = 0; s < N; ++s) {
            float z[BB];
#pragma unroll
            for (int j = 0; j < BB; j += 8) { const u32x4 raw = *(const LAS u32x4*)(Zin + s * 16 + b0 + j);
                z[j] = bflo(raw.x); z[j + 1] = bfhi(raw.x); z[j + 2] = bflo(raw.y); z[j + 3] = bfhi(raw.y); z[j + 4] = bflo(raw.z); z[j + 5] = bfhi(raw.z); z[j + 6] = bflo(raw.w); z[j + 7] = bfhi(raw.w); }
#pragma unroll
            for (int i = 0; i < TT; ++i) { const float gv = Gs[s - tt[i] + N - 1];
#pragma unroll
                for (int j = 0; j < BB; ++j) acc[i][j] += gv * z[j]; }
        }
        const float dskip = p.hy_bias[((size_t)l * 2 + order) * 256 + ch];
#pragma unroll
        for (int i = 0; i < TT; ++i)
#pragma unroll
            for (int j = 0; j < BB; ++j) { const int b = b0 + j, t = tt[i]; const float zin = bf2f(Zin[t * 16 + b]); const float gate = sconv(1 + order, b, t);
                const float y = gate * (acc[i][j] + dskip * zin);
                if (order == 0) Zout[t * 16 + b] = (bf16_t)f2bf(y);
                else MIX[((size_t)b * TPB + (LAT ? 0 : LSEQ) + t) * DM + 512 + ch] = (bf16_t)f2bf(y);
                asm volatile("" ::: "memory"); }
        }
    }
}
__device__ __forceinline__ void ph_hyena_naive(const Prm& p, int l, LAS unsigned char* lds) {
    const int nunits = (l == NLAYER - 1) ? 256 : 512;
    for (int u = bid_(); u < nunits; u += nblk_()) {
        if (u < 256) hyena_unit<LSEQ, 2, 16, 2>(p, l, u, lds); else hyena_unit<LCTX, 1, 8, 1>(p, l, u - 256, lds);
    }
}


constexpr int HY_C1 = 8192 + 64;
constexpr int HY_Z = 20480;
template <int N, int ROWT, bool INPLACE = false>
__device__ __forceinline__ void hyena_mfma_unit(const Prm& p, int l, int ch, LAS unsigned char* lds, int zoff = HY_Z) {
    constexpr int NJ = N / 32, W = ROWT, UN = W / 2; constexpr bool LAT = (N == LSEQ);
    const int tid = tid_(), lane = tid & 63, wid = tid >> 6, fr = lane & 15, fq = lane >> 4; unsigned char* ws = p.ws;
    const bf16_t* hyt = LAT ? (const bf16_t*)(ws + O_HYT) : (const bf16_t*)(ws + O_HYTC);
    const bf16_t* gf = LAT ? (const bf16_t*)(ws + O_GFL) + (size_t)l * 512 * 4096 : (const bf16_t*)(ws + O_GFC) + (size_t)l * 512 * 512;
    bf16_t* MIX = (bf16_t*)(ws + O_MIX);
    const float* sw = p.hy_sw + (size_t)l * 3 * 768; const float* sb = p.hy_sb + (size_t)l * 768;
    LAS unsigned char* Zc = lds + zoff;
    __syncthreads();
    { const int c = ch; const float w0 = sw[c], w1 = sw[768 + c], w2 = sw[2 * 768 + c], bb = sb[c];
      constexpr int NI = (N / 8) * 16 / NT > 0 ? (N / 8) * 16 / NT : 1;
      const bf16_t* hb = hyt + (size_t)c * NBATCH * N; u32x4 raw[NI]; bf16_t lo[NI], hi[NI];
#pragma unroll
      for (int q = 0; q < NI; ++q) { const int item = tid + q * NT; const bool ok = item < (N / 8) * 16; const int chunk = item >> 4, b = item & 15, t0 = chunk * 8; const unsigned o = (unsigned)(b * N + t0);
          const int oc_ = ok ? (int)o : 8; raw[q] = *(const u32x4*)(hb + oc_); lo[q] = hb[oc_ - 1]; hi[q] = hb[oc_ + 8]; }
#pragma unroll
      for (int q = 0; q < NI; ++q) { const int item = tid + q * NT; if (item < (N / 8) * 16) { float u[10];
          const int t0_ = (item >> 4) * 8; u[0] = bf2f(lo[q]) * (t0_ > 0 ? 1.f : 0.f); u[9] = bf2f(hi[q]) * (t0_ + 8 < N ? 1.f : 0.f);
          u[1] = bflo(raw[q].x); u[2] = bfhi(raw[q].x); u[3] = bflo(raw[q].y); u[4] = bfhi(raw[q].y); u[5] = bflo(raw[q].z); u[6] = bfhi(raw[q].z); u[7] = bflo(raw[q].w); u[8] = bfhi(raw[q].w);
          float o[8];
#pragma unroll
          for (int k = 0; k < 8; ++k) o[k] = bb + w0 * u[k] + w1 * u[k + 1] + w2 * u[k + 2];
          *(LAS u32x4*)(Zc + item * 16) = (u32x4){pk2(o[0], o[1]), pk2(o[2], o[3]), pk2(o[4], o[5]), pk2(o[6], o[7])}; } } }
    const int tw = ROWT * 16 * wid, c0 = 8 * fq - fr + (N - 1) - tw, par = c0 & 1;
    const LAS unsigned char* tp = lds + (par ? HY_C1 : 0) + (c0 - par) * 2;
#pragma unroll 1
    for (int order = 0; order < 2; ++order) {
        __syncthreads();
        { const unsigned* g32 = (const unsigned*)(gf + ((size_t)order * 256 + ch) * (2 * N));
          constexpr int ND = N / NT > 0 ? N / NT : 1; unsigned ga[ND], gb[ND];
#pragma unroll
          for (int q = 0; q < ND; ++q) { const int d = tid + q * NT; ga[q] = d < N ? g32[d] : 0u; gb[q] = (d + 1 < N) ? g32[d + 1] : 0u; }
#pragma unroll
          for (int q = 0; q < ND; ++q) { const int d = tid + q * NT; if (d < N) { *(LAS unsigned*)(lds + d * 4) = ga[q]; *(LAS unsigned*)(lds + HY_C1 + d * 4) = (ga[q] >> 16) | (gb[q] << 16); } } }
        __syncthreads();
        f32x4 acc[ROWT];
#pragma unroll
        for (int i = 0; i < ROWT; ++i) acc[i] = (f32x4){0.f, 0.f, 0.f, 0.f};
        u32x4 Tw[W];
#pragma unroll
        for (int d = 1 - W; d <= 0; ++d) { const LAS unsigned* q = (const LAS unsigned*)(tp + 32 * d); Tw[(d + W) % W] = (u32x4){q[0], q[1], q[2], q[3]}; }
        bf16x8 zf = *(const LAS bf16x8*)(Zc + ((4 * 0 + fq) * 16 + fr) * 16);
#pragma unroll 1
        for (int j0 = 0; j0 < NJ; j0 += UN) {
#pragma unroll
            for (int r = 0; r < UN; ++r) {
                const int j = j0 + r;
#pragma unroll
                for (int it = ROWT - 1; it >= (ROWT >= 2 ? ROWT - 2 : 0); --it)
                    acc[it] = __builtin_amdgcn_mfma_f32_16x16x32_bf16(__builtin_bit_cast(bf16x8, Tw[(2 * r - it + 4 * W) % W]), zf, acc[it], 0, 0, 0);
                { const LAS unsigned* q = (const LAS unsigned*)(tp + 32 * (2 * j + 1)); Tw[(2 * r + 1) % W] = (u32x4){q[0], q[1], q[2], q[3]}; }
                { const LAS unsigned* q = (const LAS unsigned*)(tp + 32 * (2 * j + 2)); Tw[(2 * r + 2) % W] = (u32x4){q[0], q[1], q[2], q[3]}; }
                const bf16x8 zn = *(const LAS bf16x8*)(Zc + ((4 * ((j + 1) & (NJ - 1)) + fq) * 16 + fr) * 16);
#pragma unroll
                for (int it = ROWT - 3; it >= 0; --it)
                    acc[it] = __builtin_amdgcn_mfma_f32_16x16x32_bf16(__builtin_bit_cast(bf16x8, Tw[(2 * r - it + 4 * W) % W]), zf, acc[it], 0, 0, 0);
                zf = zn;
                __builtin_amdgcn_sched_barrier(0);
            }
        }
        __syncthreads();
        const int part = 1 + order, cg = part * 256 + ch; const float w0 = sw[cg], w1 = sw[768 + cg], w2 = sw[2 * 768 + cg], bb = sb[cg];
        const float dskip = p.hy_bias[((size_t)l * 2 + order) * 256 + ch];
        const bf16_t* ub = hyt + (size_t)cg * NBATCH * N;
        unsigned uoff = (unsigned)(fr * N + tw + 4 * fq); asm volatile("" : "+v"(uoff));
        bf16_t* mb = MIX + 512 + ch; unsigned moff = (unsigned)((fr * TPB + (LAT ? 0 : LSEQ) + tw + 4 * fq) * DM); asm volatile("" : "+v"(moff));
        u32x2 mid[ROWT]; bf16_t ulo[ROWT], uhi[ROWT];
#pragma unroll
        for (int it = 0; it < ROWT; ++it) { const int t4 = tw + 16 * it + 4 * fq; const unsigned uo = uoff + 16u * it;
            mid[it] = *(const u32x2*)(ub + uo); ulo[it] = ub[(int)uo - 1]; uhi[it] = ub[(int)uo + 4]; }
#pragma unroll
        for (int it = 0; it < ROWT; ++it) {
            const int t4 = tw + 16 * it + 4 * fq; float u[6];
            u[0] = bf2f(ulo[it]) * (t4 > 0 ? 1.f : 0.f); u[5] = bf2f(uhi[it]) * (t4 + 4 < N ? 1.f : 0.f); u[1] = bflo(mid[it].x); u[2] = bfhi(mid[it].x); u[3] = bflo(mid[it].y); u[4] = bfhi(mid[it].y);
            LAS u32x2* zp = (LAS u32x2*)(Zc + (((t4 >> 3) * 16 + fr) * 8 + (t4 & 7)) * 2); const u32x2 zin = *zp;
            const float z0 = bflo(zin.x), z1 = bfhi(zin.x), z2 = bflo(zin.y), z3 = bfhi(zin.y); float y[4];
            y[0] = (bb + w0 * u[0] + w1 * u[1] + w2 * u[2]) * (acc[it][0] + dskip * z0); y[1] = (bb + w0 * u[1] + w1 * u[2] + w2 * u[3]) * (acc[it][1] + dskip * z1);
            y[2] = (bb + w0 * u[2] + w1 * u[3] + w2 * u[4]) * (acc[it][2] + dskip * z2); y[3] = (bb + w0 * u[3] + w1 * u[4] + w2 * u[5]) * (acc[it][3] + dskip * z3);
            if (order == 0 || INPLACE) { u32x2 o; o.x = pk2(y[0], y[1]); o.y = pk2(y[2], y[3]); *zp = o; }
            else { const unsigned mo = moff + (unsigned)(16 * it * DM);
#pragma unroll
                for (int r = 0; r < 4; ++r) mb[mo + (unsigned)(r * DM)] = (bf16_t)f2bf(y[r]); }
        }
    }
}
__device__ __forceinline__ void hyena_pair_unit(const Prm& p, int l, int ch0, LAS unsigned char* lds) {
    hyena_mfma_unit<LSEQ, 16, true>(p, l, ch0, lds, HY_Z);
    hyena_mfma_unit<LSEQ, 16, true>(p, l, ch0 + 1, lds, HY_Z + 65536);
    __syncthreads();
    const int tid = tid_(); bf16_t* mb = (bf16_t*)(p.ws + O_MIX) + 512 + ch0;
#pragma unroll 1
    for (int q = 0; q < 8; ++q) { const int item = tid + q * NT, chunk = item >> 4, b = item & 15;
        const u32x4 a = *(const LAS u32x4*)(lds + HY_Z + item * 16), c = *(const LAS u32x4*)(lds + HY_Z + 65536 + item * 16);
        unsigned* o = (unsigned*)(mb + (size_t)(b * TPB + chunk * 8) * DM);
        o[0 * (DM / 2)] = (a.x & 0xffffu) | (c.x << 16);          o[1 * (DM / 2)] = (a.x >> 16) | (c.x & 0xffff0000u);
        o[2 * (DM / 2)] = (a.y & 0xffffu) | (c.y << 16);          o[3 * (DM / 2)] = (a.y >> 16) | (c.y & 0xffff0000u);
        o[4 * (DM / 2)] = (a.z & 0xffffu) | (c.z << 16);          o[5 * (DM / 2)] = (a.z >> 16) | (c.z & 0xffff0000u);
        o[6 * (DM / 2)] = (a.w & 0xffffu) | (c.w << 16);          o[7 * (DM / 2)] = (a.w >> 16) | (c.w & 0xffff0000u); }
}
__device__ __forceinline__ void ph_hyena(const Prm& p, int l, LAS unsigned char* lds) {
    const int nunits = (l == NLAYER - 1) ? 256 : 512;
    for (int u = bid_(); u < nunits; u += nblk_()) {
        if (u < 256) hyena_mfma_unit<LSEQ, 16>(p, l, u, lds); else hyena_mfma_unit<LCTX, 2>(p, l, u - 256, lds);
    }
}

__device__ __forceinline__ void ph_norm2(const Prm& p, int l, LAS unsigned char* lds, const int rb, const int re, const int nb) {
    if (bid_() >= nb || rb >= re) return;
    const int tid = tid_(), lane = tid & 63, wv = tid >> 6; unsigned char* ws = p.ws;
    const bf16_t* xs = (const bf16_t*)(ws + O_XS); unsigned char* H8 = (unsigned char*)(ws + O_H); const float* modv = (const float*)(ws + O_MODV); float* aff = (float*)(ws + O_AFF);
    const float* wr = p.w_router + (size_t)l * DM * NEXP;
    __syncthreads();
    for (int i = tid; i < DM * 4; i += NT) { const int k = i >> 2, e4 = i & 3; const int rowp = (k & 3) * 256 + (k >> 2); *(LAS f32x4*)(lds + rowp * 80 + e4 * 16) = *(const f32x4*)(wr + (size_t)k * 16 + e4 * 4); }
    __syncthreads();
    LAS float* mv = (LAS float*)(lds + 1024 * 80);
    const int rpb = ((((re - rb) + nb - 1) / nb) + 1) & ~1; const int i0 = rb + bid_() * rpb; const int i1 = (i0 + rpb < re) ? i0 + rpb : re;
    u32x2 nv[2][4]; u32x2 ny[2][4]; const bf16_t* Y16 = (const bf16_t*)(ws + O_MIX);
#pragma unroll 1
    for (int s0 = i0; s0 < i1; ) {
      const int b = s0 / TPB, t0 = s0 % TPB; const bool isctx = t0 >= LSEQ; const int mrow = isctx ? 16 : b;
      const int segend = b * TPB + (isctx ? TPB : LSEQ); const int s1 = segend < i1 ? segend : i1;
      if (isctx && l == NLAYER - 1) { s0 = s1; continue; }
      __syncthreads();
      { const float* ml = modv + ((size_t)l * 17 + mrow) * 6144;
        for (int i = tid; i < 768; i += NT) { const int which = i >> 8, c = (i & 255) * 4; f32x4 val;
            if (which == 0) val = *(const f32x4*)(ml + 2 * 1024 + c);
            else if (which == 1) val = *(const f32x4*)(p.norm2_g + l * DM + c) * (*(const f32x4*)(ml + 4 * 1024 + c) + 1.0f);
            else val = *(const f32x4*)(ml + 3 * 1024 + c);
            *(LAS f32x4*)(mv + which * 1024 + c) = val; } }
      __syncthreads();
      int r = s0 + wv * 2;
      if (r < s1) {
#pragma unroll
        for (int rr = 0; rr < 2; ++rr)
#pragma unroll
            for (int q = 0; q < 4; ++q) { nv[rr][q] = *(const u32x2*)(xs + (size_t)(r + rr) * DM + q * 256 + lane * 4); ny[rr][q] = *(const u32x2*)(Y16 + (size_t)(r + rr) * DM + q * 256 + lane * 4); } }
#pragma unroll 1
      for (; r < s1; r += 16) {
        f32x4 v[2][4]; float ss[2] = {0.f, 0.f};
#pragma unroll
        for (int q = 0; q < 4; ++q) { const f32x4 g1 = *(const LAS f32x4*)(mv + q * 256 + lane * 4);
#pragma unroll
            for (int rr = 0; rr < 2; ++rr) { f32x4 w = {bflo(nv[rr][q].x), bfhi(nv[rr][q].x), bflo(nv[rr][q].y), bfhi(nv[rr][q].y)}; w[0] += g1[0] * bflo(ny[rr][q].x); w[1] += g1[1] * bfhi(ny[rr][q].x); w[2] += g1[2] * bflo(ny[rr][q].y); w[3] += g1[3] * bfhi(ny[rr][q].y);
                v[rr][q] = w; ss[rr] += w[0] * w[0] + w[1] * w[1] + w[2] * w[2] + w[3] * w[3]; } }
        if (r + 16 < s1) {
#pragma unroll
            for (int rr = 0; rr < 2; ++rr)
#pragma unroll
                for (int q = 0; q < 4; ++q) { nv[rr][q] = *(const u32x2*)(xs + (size_t)(r + 16 + rr) * DM + q * 256 + lane * 4); ny[rr][q] = *(const u32x2*)(Y16 + (size_t)(r + 16 + rr) * DM + q * 256 + lane * 4); } }
        float rstd[2];
#pragma unroll
        for (int rr = 0; rr < 2; ++rr) { const float s_ = wave_sum(ss[rr]); rstd[rr] = rsqrtf(s_ * (1.0f / DM) + EPS); }
        __builtin_amdgcn_sched_barrier(0);
        asm volatile("" : "+v"(rstd[0]), "+v"(rstd[1]));
        f32x4 h[2][4];
#pragma unroll
        for (int q = 0; q < 4; ++q) { const int c = q * 256 + lane * 4;
            const f32x4 ga = *(const LAS f32x4*)(mv + 1024 + c), sh = *(const LAS f32x4*)(mv + 2048 + c);
#pragma unroll
            for (int rr = 0; rr < 2; ++rr) { h[rr][q] = (v[rr][q] * rstd[rr]) * ga + sh; *(unsigned*)(H8 + (size_t)(r + rr) * DM + c) = pk4_fp8(h[rr][q][0], h[rr][q][1], h[rr][q][2], h[rr][q][3]); } }
        __builtin_amdgcn_sched_barrier(0);
        typedef float f2_ __attribute__((ext_vector_type(2))); f2_ lg[16]; unsigned wofs = (unsigned)lane * 80u;        asm volatile("" : "+v"(wofs));
#pragma unroll
        for (int e = 0; e < 16; ++e) lg[e] = (f2_){0.f, 0.f};
#pragma unroll
        for (int q = 0; q < 4; ++q) {
#pragma unroll
            for (int j = 0; j < 4; ++j) { const LAS unsigned char* wrow = lds + (j * 256 + q * 64) * 80 + wofs;
                f32x4 w[4];
#pragma unroll
                for (int e4 = 0; e4 < 4; ++e4) w[e4] = *(const LAS f32x4*)(wrow + e4 * 16);
#pragma unroll
                for (int e4 = 0; e4 < 4; ++e4) { const f2_ hp = {h[0][q][j], h[1][q][j]};
#pragma unroll
                    for (int k = 0; k < 4; ++k) lg[e4 * 4 + k] += hp * (f2_){w[e4][k], w[e4][k]}; }
                __builtin_amdgcn_sched_barrier(0);
            } }
        asm volatile("" : "+v"(lg[0]), "+v"(lg[1]), "+v"(lg[2]), "+v"(lg[3]), "+v"(lg[4]), "+v"(lg[5]), "+v"(lg[6]), "+v"(lg[7]));
        asm volatile("" : "+v"(lg[8]), "+v"(lg[9]), "+v"(lg[10]), "+v"(lg[11]), "+v"(lg[12]), "+v"(lg[13]), "+v"(lg[14]), "+v"(lg[15]));
#pragma unroll
        for (int rr = 0; rr < 2; ++rr) {
        float r8[8], r4[4], r2[2], r1;
        { const bool up = (lane & 32) != 0;
#pragma unroll
          for (int i = 0; i < 8; ++i) { const float keep = up ? lg[8 + i][rr] : lg[i][rr], give = up ? lg[i][rr] : lg[8 + i][rr]; r8[i] = keep + __shfl_xor(give, 32); } }
        { const bool up = (lane & 16) != 0;
#pragma unroll
          for (int i = 0; i < 4; ++i) { const float keep = up ? r8[4 + i] : r8[i], give = up ? r8[i] : r8[4 + i]; r4[i] = keep + __shfl_xor(give, 16); } }
        { const bool up = (lane & 8) != 0;
#pragma unroll
          for (int i = 0; i < 2; ++i) { const float keep = up ? r4[2 + i] : r4[i], give = up ? r4[i] : r4[2 + i]; r2[i] = keep + __shfl_xor(give, 8); } }
        { const bool up = (lane & 4) != 0; const float keep = up ? r2[1] : r2[0], give = up ? r2[0] : r2[1]; r1 = keep + __shfl_xor(give, 4); }
        r1 += __shfl_xor(r1, 2); r1 += __shfl_xor(r1, 1);
        float mxv = r1;
        mxv = fmaxf(mxv, __shfl_xor(mxv, 32)); mxv = fmaxf(mxv, __shfl_xor(mxv, 16)); mxv = fmaxf(mxv, __shfl_xor(mxv, 8)); mxv = fmaxf(mxv, __shfl_xor(mxv, 4));
        const float ex = expf(r1 - mxv); float den = ex;
        den += __shfl_xor(den, 32); den += __shfl_xor(den, 16); den += __shfl_xor(den, 8); den += __shfl_xor(den, 4);
        const int e = ((lane >> 5) & 1) * 8 + ((lane >> 4) & 1) * 4 + ((lane >> 3) & 1) * 2 + ((lane >> 2) & 1);
        if ((lane & 3) == 0) aff[(size_t)(r + rr) * 16 + e] = ex / den;
        __builtin_amdgcn_sched_barrier(0);
        }
      }
      s0 = s1;
    }
}

__device__ __forceinline__ void ph_topk(const Prm& p, int l, LAS unsigned char* lds) {
    const int tid = tid_(); unsigned char* ws = p.ws;
    const float* aff = (const float*)(ws + O_AFF); int* sel = (int*)(ws + O_SEL); int* idx = (int*)(ws + O_IDX);
    LAS unsigned long long* key = (LAS unsigned long long*)lds;
    const int nunits = (l == NLAYER - 1) ? 256 : 512;
    for (int u = bid_(); u < nunits; u += nblk_()) {
        const bool isctx = u >= 256; const int b = (u & 255) >> 4, e = u & 15; const int n = isctx ? LCTX : LSEQ, cap = isctx ? CAP_C : CAP_L; const int row0 = b * TPB + (isctx ? LSEQ : 0);
        __syncthreads();
        for (int t = tid; t < n; t += NT) key[t] = ((unsigned long long)__float_as_uint(aff[(size_t)(row0 + t) * 16 + e]) << 32) | (unsigned)(0xffffffffu - (unsigned)t);
        __syncthreads();
        const int SEG = n >> 3, wv_ = tid >> 6, ln_ = tid & 63;
        for (int k = 2; k <= n; k <<= 1) {
            for (int j = k >> 1; j > 0; j >>= 1) {
                if (j >= SEG) {
                    __syncthreads();
                    for (int q = tid; q < (n >> 1); q += NT) {
                        const int i = ((q & ~(j - 1)) << 1) | (q & (j - 1)), ix = i | j;
                        const unsigned long long a = key[i], c = key[ix]; const bool desc = ((i & k) == 0);
                        if ((a < c) == desc) { key[i] = c; key[ix] = a; }
                    }
                    if (j == SEG) __syncthreads();
                } else {
                    for (int q = ln_; q < (SEG >> 1); q += 64) {
                        const int i = wv_ * SEG + (((q & ~(j - 1)) << 1) | (q & (j - 1))), ix = i | j;
                        const unsigned long long a = key[i], c = key[ix]; const bool desc = ((i & k) == 0);
                        if ((a < c) == desc) { key[i] = c; key[ix] = a; }
                    }
                    asm volatile("s_waitcnt lgkmcnt(0)" ::: "memory");
                }
            }
        }
        __syncthreads();
        for (int r = tid; r < n; r += NT) { const int t = (int)(0xffffffffu - (unsigned)key[r]);
            const int slot = isctx ? (4096 + b * CAP_C + r) : (b * CAP_L + r);
            if (r < cap) { idx[e * EROWS + slot] = row0 + t; sel[(size_t)(row0 + t) * 16 + e] = slot; } else sel[(size_t)(row0 + t) * 16 + e] = -1; }
        { const unsigned char* H8 = (const unsigned char*)(ws + O_H); unsigned char* XG = (unsigned char*)(ws + O_XG8) + ((size_t)e * EROWS + (isctx ? (4096 + b * CAP_C) : (b * CAP_L))) * DM;
          const int lane = tid & 63, wv = tid >> 6;
          if (isctx) { const int r0 = wv * 4; u32x4 v[4];
#pragma unroll
              for (int q = 0; q < 4; ++q) { const int t = (int)(0xffffffffu - (unsigned)key[r0 + q]); v[q] = *(const u32x4*)(H8 + (size_t)(row0 + t) * DM + lane * 16); }
#pragma unroll
              for (int q = 0; q < 4; ++q) *(u32x4*)(XG + (size_t)(r0 + q) * DM + lane * 16) = v[q]; }
          else {
#pragma unroll 1
              for (int r0 = wv * 16; r0 < cap; r0 += 128) { u32x4 v[16];
#pragma unroll
                  for (int q = 0; q < 16; ++q) { const int t = (int)(0xffffffffu - (unsigned)key[r0 + q]); v[q] = *(const u32x4*)(H8 + (size_t)(row0 + t) * DM + lane * 16); }
#pragma unroll
                  for (int q = 0; q < 16; ++q) *(u32x4*)(XG + (size_t)(r0 + q) * DM + lane * 16) = v[q]; } } }
    }
}

struct SchedG1a { const bf16_t *H, *WM; int g, c, lat;
    __device__ __forceinline__ bool next(int i, GU& u) const { int pm, pn; const int L = i * g + c;
        if (!lat) { if (!tile_order(L, 144, 3, pm, pn)) return false; }
        else if (L < 128 * 3) { tile_order(L, 128, 3, pm, pn); pm = (pm >> 3) * 9 + (pm & 7); }
        else if (L < 128 * 3 + 16) { pm = (L - 128 * 3) * 9 + 8; pn = 2; }
        else return false;
        u.gidx = nullptr; u.lda = 512; u.ldb = 512; u.nt = 8; u.A = H + (size_t)pm * BM * 512; u.B = WM + (size_t)pn * BM * 512; u.i0 = pm; u.i1 = pn; u.i2 = 0; u.i3 = 0; return true; } };
struct SchedG1g { const bf16_t *H8, *WG; int g, c, lat;
    __device__ __forceinline__ bool next(int i, GU& u) const { int pm, pn; if (!tile_order(i * g + c, lat ? 128 : 144, 12, pm, pn)) return false;
        if (lat) pm = (pm >> 3) * 9 + (pm & 7);
        u.gidx = nullptr; u.lda = 512; u.ldb = 512; u.nt = 8; u.A = H8 + (size_t)pm * BM * 512; u.B = WG + (size_t)pn * BM * 512; u.i0 = pm; u.i1 = pn; u.i2 = 0; u.i3 = 0; return true; } };
struct SchedG1b { const bf16_t *H, *WS; int g, c, lat;
    __device__ __forceinline__ bool next(int i, GU& u) const { int pn, pm; if (!tile_order(i * g + c, 5, lat ? 128 : 144, pn, pm)) return false;
        if (lat) pm = (pm >> 3) * 9 + (pm & 7);
        u.gidx = nullptr; u.lda = DM; u.ldb = DM; u.nt = 16; u.A = WS + (size_t)pn * BM * DM; u.B = H + (size_t)pm * BM * DM; u.i0 = pn; u.i1 = pm; u.i2 = 1; u.i3 = 0; return true; } };
__device__ __forceinline__ void ph_g1(const Prm& p, int l, LAS unsigned char* lds) {
    unsigned char* ws = p.ws; const int lat = (l == NLAYER - 1) ? 1 : 0;
    { SchedG1g S{(const bf16_t*)(ws + O_H8G), (const bf16_t*)(ws + O_WG8 + (size_t)l * 3072 * DM), nblk_(), bid_(), lat}; EpiGate E{(bf16_t*)(ws + O_PM)}; gemm_fast<false, 0, true>(lds, S, E, 512, 512, 8); }
    { SchedG1a S{(const bf16_t*)(ws + O_H8G), (const bf16_t*)(ws + O_WINM) + (size_t)l * PMW * DM, nblk_(), bid_(), lat}; EpiPm E{(bf16_t*)(ws + O_PM), (bf16_t*)(ws + O_QP), (bf16_t*)(ws + O_KP), p.q_gain + l * 64, p.k_gain + l * 64, (const float*)(ws + O_ROPE)}; gemm_fast<false, 0, true>(lds, S, E, 512, 512, 8); }
    { SchedG1b S{(const bf16_t*)(ws + O_H), (const bf16_t*)(ws + O_WINS) + (size_t)l * SWR * DM, nblk_(), bid_(), lat}; EpiSw E{(bf16_t*)(ws + O_HYT), (bf16_t*)(ws + O_HYTC), (bf16_t*)(ws + O_PQT), (bf16_t*)(ws + O_PQTC)}; gemm_fast<false>(lds, S, E, DM, DM, 16); }
}
__device__ __forceinline__ void ph_fnet(const Prm& p, int l, LAS unsigned char* lds) {
    unsigned char* ws = p.ws; EpiBf E{(bf16_t*)(ws + O_MIX), DM, 1.0f};
    { SchedFnL S{(const bf16_t*)(ws + O_DFTM), (const bf16_t*)(ws + O_PQT), nblk_(), bid_()}; gemm_fast<false>(lds, S, E, 4096, 4096, 64); }
    if (l != NLAYER - 1) { SchedFnC S{(const bf16_t*)(ws + O_DFTC), (const bf16_t*)(ws + O_PQTC), nblk_(), bid_()}; gemm_fast<false>(lds, S, E, 512, 512, 8); }
}
__device__ __forceinline__ void ph_merge_part(const Prm& p, int l, LAS unsigned char* lds, int lat, int p0, int np) {
    unsigned char* ws = p.ws; EpiMerge E{(const bf16_t*)(ws + O_PM), (bf16_t*)(ws + O_M)};
    SchedSq S{(const bf16_t*)(ws + O_MIX), (const bf16_t*)(ws + O_WBT) + (size_t)l * DM * DM, nblk_(), bid_(), lat, p0, np, 0};
    gemm_fast<false, 1>(lds, S, E, DM, DM, 16);
}
__device__ __forceinline__ void ph_wout_part(const Prm& p, int l, LAS unsigned char* lds, int lat, int p0, int np, int rev) {
    unsigned char* ws = p.ws; SchedSq S{(const bf16_t*)(ws + O_M), (const bf16_t*)(ws + O_WOT) + (size_t)l * DM * DM, nblk_(), bid_(), lat, p0, np, rev};
    EpiY E{(bf16_t*)(ws + O_MIX)};
    gemm_fast<false>(lds, S, E, DM, DM, 16);
}
__device__ __forceinline__ void ph_moe_up(const Prm& p, int l, LAS unsigned char* lds) {
    unsigned char* ws = p.ws; SchedUp S{(const bf16_t*)(ws + O_XG8), (const bf16_t*)(ws + O_WGU + (size_t)l * NEXP * 4096 * DM), (const int*)(ws + O_IDX), nblk_(), bid_(), (l == NLAYER - 1) ? 16 : 18};
    EpiGlu E{(unsigned char*)(ws + O_HID)};
    gemm_fast<false, 0, true>(lds, S, E, 512, 512, 8);
}
__device__ __forceinline__ void ph_moe_down(const Prm& p, int l, LAS unsigned char* lds) {
    unsigned char* ws = p.ws; SchedDown S{(const bf16_t*)(ws + O_HID), (const bf16_t*)(ws + O_WDT + (size_t)l * NEXP * DM * FF), nblk_(), bid_(), (l == NLAYER - 1) ? 16 : 18};
    EpiF8 E{(unsigned char*)(ws + O_Y), DM, (W8I / H8S) * Y8S};
    gemm_fast<false, 0, true>(lds, S, E, 1024, 1024, 16);
}

#define XB_TMO      128
#define XB_XCNT(j)  (256  + 64 * (j))
#define XB_XSUB(j)  (1280 + 64 * (j))
#define XB_XGEN(j)  (2304 + 64 * (j))
#define XB_TOP      3328
#define XB_TOPGEN   3392
#define XCD_BAR_WORDS 3456
#define XB_SPIN_CAP (1u << 18)
__device__ __forceinline__ unsigned xb_ld(unsigned* p)              { return __hip_atomic_load(p, __ATOMIC_RELAXED, __HIP_MEMORY_SCOPE_AGENT); }
__device__ __forceinline__ unsigned xb_add(unsigned* p, unsigned v) { return __hip_atomic_fetch_add(p, v, __ATOMIC_RELAXED, __HIP_MEMORY_SCOPE_AGENT); }
__device__ __forceinline__ unsigned xb_xcc_id() { return (unsigned)__builtin_amdgcn_s_getreg((3 << 11) | 20) & 0xFu; }
#define XB_SPIN(cond, bar) do { unsigned _sp = 0; while (cond) { __builtin_amdgcn_s_sleep(1); \
    if ((++_sp & 255u) == 0u) { if (xb_ld(&(bar)[XB_TMO])) break; if (_sp > XB_SPIN_CAP) { atomicAdd(&(bar)[XB_TMO], 1u); break; } } } } while (0)
struct XcdBarrier { unsigned* bar; unsigned x; volatile LAS unsigned* st; };
__device__ __forceinline__ XcdBarrier xcd_barrier_post(unsigned* bar, volatile LAS unsigned* st) {
    XcdBarrier b; b.bar = bar; b.x = xb_xcc_id(); b.st = st;
    if (threadIdx.x == 0) (void)xb_add(&bar[XB_XCNT(b.x)], 1u);
    return b;
}
__device__ __forceinline__ void xcd_barrier_complete(unsigned* bar, unsigned x, unsigned& nloc, unsigned& nx) {
    const unsigned G = gridDim.x * gridDim.y * gridDim.z;
    unsigned sum, cnt, mine, sp = 0u;
    for (;;) {
        sum = 0u; cnt = 0u; mine = 0u;
#pragma unroll
        for (unsigned j = 0; j < 16; ++j) { const unsigned c = xb_ld(&bar[XB_XCNT(j)]); sum += c; cnt += (c > 0u) ? 1u : 0u; mine = (j == x) ? c : mine; }
        if (sum == G) break;
        __builtin_amdgcn_s_sleep(1);
        if ((++sp & 255u) == 0u) { if (xb_ld(&bar[XB_TMO])) break; if (sp > XB_SPIN_CAP) { atomicAdd(&bar[XB_TMO], 1u); break; } }
    }
    nloc = mine > 0u ? mine : 1u; nx = cnt > 0u ? cnt : 1u;
}
__device__ __forceinline__ void xcd_barrier(const XcdBarrier& b) {
    asm volatile("s_waitcnt vmcnt(0)" ::: "memory");
    __syncthreads();
    if (threadIdx.x == 0) {
        unsigned* bar = b.bar;
        __builtin_amdgcn_s_waitcnt(0);
        unsigned nloc = b.st[0], nx = b.st[1];
        if (nloc == 0u) { xcd_barrier_complete(bar, b.x, nloc, nx); b.st[0] = nloc; b.st[1] = nx; }
        const unsigned old = xb_add(&bar[XB_XSUB(b.x)], 1u);
        const unsigned gen = old / nloc;
        if (old + 1u == (gen + 1u) * nloc) {
            __builtin_amdgcn_fence(__ATOMIC_RELEASE, "agent");
            asm volatile("s_waitcnt vmcnt(0)" ::: "memory");
            const unsigned og = xb_add(&bar[XB_TOP], 1u);
            const unsigned tg = og / nx;
            if (og + 1u == (tg + 1u) * nx) xb_add(&bar[XB_TOPGEN], 1u);
            else XB_SPIN(xb_ld(&bar[XB_TOPGEN]) == tg, bar);
            __builtin_amdgcn_fence(__ATOMIC_ACQUIRE, "agent");
            xb_add(&bar[XB_XGEN(b.x)], 1u);
            asm volatile("s_waitcnt vmcnt(0)" ::: "memory");
        } else {
            XB_SPIN(xb_ld(&bar[XB_XGEN(b.x)]) == gen, bar);
            __builtin_amdgcn_fence(__ATOMIC_ACQUIRE, "agent");
            asm volatile("s_waitcnt vmcnt(0)" ::: "memory");
        }
    }
    __syncthreads();
}


struct SchedOne { GU u; __device__ __forceinline__ bool next(int i, GU& o) const { if (i != 0) return false; o = u; return true; } };
__device__ __forceinline__ float attn_negc(const Prm& p, int l) {
    const int lane = tid_() & 63;
    float gq = fabsf(p.q_gain[l * 64 + lane]), gk = fabsf(p.k_gain[l * 64 + lane]);
#pragma unroll
    for (int o = 32; o; o >>= 1) { gq = fmaxf(gq, __shfl_xor(gq, o)); gk = fmaxf(gk, __shfl_xor(gk, o)); }
    return __builtin_bit_cast(float, __builtin_amdgcn_readfirstlane(__builtin_bit_cast(int, -(64.0f * 0.125f * 1.4426950408889634f * 1.02f) * gq * gk)));
}
__device__ __forceinline__ void ph_mix(const Prm& p, int l, LAS unsigned char* lds, char* shm, int qset = 0) {
    using attn_body::bf16;
    unsigned char* ws = p.ws; const bool lastl = (l == NLAYER - 1); const int nper = lastl ? 160 : 210;
    unsigned* qbase = (unsigned*)(ws + O_QCNT) + 64 * (1 + l * 8 + qset * 32);
    LAS unsigned* slot = (LAS unsigned*)(lds + LDS_BYTES - 32);
    const int myx = (int)(xb_xcc_id() & 7u);
#pragma unroll 1
    for (int sx = 0; sx < 8; ++sx) {
        const int x = (myx + sx) & 7;
        __syncthreads();
        if (threadIdx.x == 0) *slot = atomicAdd(qbase + 64 * x, 1u);
        __syncthreads();
#pragma unroll 1
        for (;;) {
            const int u = (int)__builtin_amdgcn_readfirstlane(*slot);
            if (u >= nper) break;
            unsigned nxtu = 0u; if (threadIdx.x == 0) nxtu = atomicAdd(qbase + 64 * x, 1u);
            __syncthreads();
            if (u < 16) {
                SchedOne S; S.u.gidx = nullptr; S.u.lda = 4096; S.u.ldb = 4096; S.u.nt = 64; S.u.i1 = 768; S.u.i2 = 0; S.u.i3 = 0;
                const int fb = x * 2 + (u >> 3), fpm = u & 7;
                S.u.A = (const bf16_t*)(ws + O_DFTM) + (size_t)fpm * BM * 4096; S.u.B = (const bf16_t*)(ws + O_PQT) + (size_t)fb * 256 * 4096; S.u.i0 = fb * TPB + fpm * 256;
                EpiBf E{(bf16_t*)(ws + O_MIX), DM, 1.0f}; gemm_fast<false>(lds, S, E, 4096, 4096, 64);
            } else if (u < 32) { hyena_pair_unit(p, l, (x * 16 + (u - 16)) * 2, lds);
            } else if (u < 160) {
                const int v = u - 32, id = x * 4 + (v >> 5), sl = v & 31, b = id >> 1, g = id & 1, h = g * 4 + (sl >> 3); const long qrow0 = (long)b * TPB + (sl & 7) * 256, krow0 = (long)b * TPB;
                attn_body::attn_unit<9999, 512, 128, PMW, DM>((const bf16*)(ws + O_QP) + qrow0 * 512 + h * 64, (const bf16*)(ws + O_KP) + krow0 * 128 + g * 64, (const bf16*)(ws + O_PM) + krow0 * PMW + 640 + g * 64, (bf16*)(ws + O_MIX) + qrow0 * DM + h * 64, 36, shm, attn_negc(p, l));
            } else if (u < 192) { hyena_mfma_unit<LCTX, 2>(p, l, x * 32 + (u - 160), lds);
            } else if (u < 208) {
                const int j = x * 16 + (u - 192), b = j >> 3, h = j & 7, g = h >> 2; const long qrow0 = (long)b * TPB + LSEQ;
                attn_body::attn_unit<9999, 512, 128, PMW, DM>((const bf16*)(ws + O_QP) + qrow0 * 512 + h * 64, (const bf16*)(ws + O_KP) + qrow0 * 128 + g * 64, (const bf16*)(ws + O_PM) + qrow0 * PMW + 640 + g * 64, (bf16*)(ws + O_MIX) + qrow0 * DM + h * 64, 4, shm, attn_negc(p, l));
            } else {
                const int b = x * 2 + (u - 208);
                SchedOne S; S.u.gidx = nullptr; S.u.lda = 512; S.u.ldb = 512; S.u.nt = 8; S.u.i1 = 768; S.u.i2 = 0; S.u.i3 = 0;
                S.u.A = (const bf16_t*)(ws + O_DFTC); S.u.B = (const bf16_t*)(ws + O_PQTC) + (size_t)b * 256 * 512; S.u.i0 = b * TPB + LSEQ;
                EpiBf E{(bf16_t*)(ws + O_MIX), DM, 1.0f}; gemm_fast<false>(lds, S, E, 512, 512, 8);
            }
            __syncthreads();
            if (threadIdx.x == 0) *slot = nxtu;
            __syncthreads();
        }
    }
}

__device__ __forceinline__ const Prm& kprm() { auto k = __builtin_amdgcn_kernarg_segment_ptr(); asm volatile("" : "+s"(k)); return *(const Prm*)k; }
#define P_ kprm()
__global__ void __launch_bounds__(NT, 2) k_mega(Prm p_unused) {
    extern __shared__ __attribute__((aligned(16))) unsigned char shm[];
    LAS unsigned char* lds = (LAS unsigned char*)shm;
    volatile LAS unsigned* st = (volatile LAS unsigned*)(lds + LDS_BYTES - 16);
    if (threadIdx.x == 0) { st[0] = 0u; st[1] = 0u; st[2] = 0u; st[3] = 0u; }
    __syncthreads();
    (void)xcd_barrier_post((unsigned*)(P_.ws + O_BAR), st);
#define GSYNC() do { XcdBarrier b_; b_.bar = (unsigned*)(P_.ws + O_BAR); b_.x = xb_xcc_id(); b_.st = (volatile LAS unsigned*)(lds + LDS_BYTES - 16); xcd_barrier(b_); } while (0)
    ph_pre1<-1>(P_, lds);
    GSYNC();
    ph_pre2(P_, lds);
    GSYNC();
#pragma unroll 1
    for (int l = 0; l < NLAYER; ++l) {
        ph_norm1(P_, l, lds);            GSYNC();
        ph_g1(P_, l, lds);               GSYNC();
        ph_mix(P_, l, lds, (char*)shm);  GSYNC();
        if (l == NLAYER - 1) { ph_merge_part(P_, l, lds, 1, 0, 128); GSYNC(); ph_wout_part(P_, l, lds, 1, 0, 128, 0); GSYNC(); }
        int n2_done = 0;
        if (l != NLAYER - 1) { ph_merge_part(P_, l, lds, 0, 0, 128); GSYNC(); ph_merge_part(P_, l, lds, 0, 128, 16); ph_wout_part(P_, l, lds, 0, 0, 112, 1); GSYNC();
            const int g_ = nblk_(), nidle = g_ > 128 ? g_ - 128 : 0, rpbf = (((NTOK + g_ - 1) / g_) + 1) & ~1; n2_done = nidle * rpbf < 112 * BM ? nidle * rpbf : 112 * BM;
            ph_wout_part(P_, l, lds, 0, 112, 32, 1);
            ph_norm2(P_, l, lds, 0, n2_done, nidle);
            GSYNC(); }
        ph_norm2(P_, l, lds, n2_done, NTOK, nblk_());            GSYNC();
        ph_topk(P_, l, lds);             GSYNC();
        ph_moe_up(P_, l, lds);           GSYNC();
        ph_moe_down(P_, l, lds);         GSYNC();
    }
    ph_norm1(P_, NLAYER, lds);
}

extern "C" void kernel_launch(void* const* d_in, const int* in_sizes, int n_in, void* d_out, int out_size, void* d_ws, size_t ws_size, hipStream_t stream) {
    Prm p; memset(&p, 0, sizeof(p));
    const float** f = (const float**)&p;
    for (int i = 0; i < 27; ++i) f[i] = (const float*)d_in[i];
    p.out = (float*)d_out; p.ws = (unsigned char*)d_ws;
    static int grid = 0;
    if (!grid) {
        int dev = 0, cus = 0, per_cu = 0;
        (void)hipGetDevice(&dev);
        (void)hipDeviceGetAttribute(&cus, hipDeviceAttributeMultiprocessorCount, dev);
        (void)hipFuncSetAttribute((const void*)k_mega, hipFuncAttributeMaxDynamicSharedMemorySize, LDS_BYTES);
        (void)hipOccupancyMaxActiveBlocksPerMultiprocessor(&per_cu, k_mega, NT, LDS_BYTES);
        if (cus <= 0) cus = 256;
        grid = cus * (per_cu < 1 ? 1 : 1);
    }
    (void)hipMemsetAsync((unsigned char*)d_ws + O_BAR, 0, 65536, stream);
    hipLaunchKernelGGL(k_mega, dim3(grid), dim3(NT), LDS_BYTES, stream, p);
}
```

```cpp
#include <hip/hip_runtime.h>
#include <stdint.h>
#include <string.h>
#include <hip/hip_bf16.h>
#include <cmath>

#define LAS __attribute__((address_space(3)))
typedef unsigned short bf16_t;
typedef short bf16x8 __attribute__((ext_vector_type(8)));
typedef float f32x4 __attribute__((ext_vector_type(4)));
typedef unsigned u32x4 __attribute__((ext_vector_type(4)));
typedef unsigned u32x2 __attribute__((ext_vector_type(2)));
typedef int i32x4 __attribute__((ext_vector_type(4)));
typedef int i32x8 __attribute__((ext_vector_type(8)));

constexpr int DM = 1024, NBATCH = 16, LSEQ = 2048, LCTX = 256, TPB = 2304, NTOK = 36864, NLAYER = 4;
constexpr int INW = 4864, OFF_HY = 768, OFF_FN = 1536, OFF_GATE = 1792;
constexpr int PMW = 3840;
constexpr int SWR = 1280;
constexpr int NEXP = 16, FF = 2048, CAP_L = 256, CAP_C = 32, EROWS = 4608;
constexpr int NT = 512;
constexpr int LDS_BYTES = 155648;
constexpr float EPS = 1e-6f;

constexpr size_t al256(size_t x) { return (x + 255) & ~(size_t)255; }
constexpr size_t O_BAR   = 0;
constexpr size_t O_QCNT  = 32768;
constexpr size_t O_WINM  = 65536;
constexpr size_t O_WINS  = O_WINM + (size_t)NLAYER * PMW * DM * 2;
constexpr size_t O_WBT   = O_WINS + (size_t)NLAYER * SWR * DM * 2;
constexpr size_t O_WOT   = O_WBT + (size_t)NLAYER * DM * DM * 2;
constexpr size_t O_WGU   = O_WOT + (size_t)NLAYER * DM * DM * 2;
constexpr size_t O_WDT   = O_WGU + (size_t)NLAYER * NEXP * 4096 * DM * 2;
constexpr size_t O_MODV  = O_WDT + (size_t)NLAYER * NEXP * DM * FF * 2;
constexpr size_t O_ROPE  = al256(O_MODV + (size_t)NLAYER * 17 * 6144 * 4);
constexpr size_t O_HRAW  = O_ROPE + (size_t)LSEQ * 32 * 2 * 4;
constexpr size_t O_GFL   = O_HRAW + (size_t)NLAYER * TPB * 1024 * 4;
constexpr size_t O_GFC   = O_GFL + (size_t)NLAYER * 2 * 256 * 4096 * 2;
constexpr size_t O_DFTM  = O_GFC + (size_t)NLAYER * 2 * 256 * 512 * 2;
constexpr size_t O_DFTC  = O_DFTM + (size_t)LSEQ * 4096 * 2;
constexpr size_t O_XS    = O_DFTC + (size_t)LCTX * 512 * 2;
constexpr size_t O_H     = O_XS + (size_t)NTOK * DM * 4;
constexpr size_t O_PM    = O_H + (size_t)NTOK * DM * 2;
constexpr size_t O_HYT   = O_PM + (size_t)NTOK * PMW * 2;
constexpr size_t O_HYTC  = O_HYT + (size_t)768 * NBATCH * LSEQ * 2;
constexpr size_t O_PQT   = O_HYTC + (size_t)768 * NBATCH * LCTX * 2;
constexpr size_t O_PQTC  = O_PQT + (size_t)NBATCH * 256 * 4096 * 2;
constexpr size_t O_QP    = O_PQTC + (size_t)NBATCH * 256 * 512 * 2;
constexpr size_t O_KP    = O_QP + (size_t)NTOK * 512 * 2;
constexpr size_t O_MIX   = O_KP + (size_t)NTOK * 128 * 2;
constexpr size_t O_M     = O_MIX + (size_t)NTOK * DM * 2;
constexpr size_t O_Y     = O_M + (size_t)NTOK * DM * 2;
constexpr size_t O_AFF   = O_Y + (size_t)NTOK * DM * 4;
constexpr size_t O_SEL   = O_AFF + (size_t)NTOK * 16 * 4;
constexpr size_t O_IDX   = O_SEL + (size_t)NTOK * 16 * 4;
constexpr size_t O_END   = O_IDX + (size_t)NEXP * EROWS * 4;
constexpr size_t O_H8G   = O_END;
constexpr size_t O_WG8   = O_H8G + (size_t)NTOK * DM;
constexpr size_t O_END2  = O_WG8 + (size_t)NLAYER * 3072 * DM;
constexpr size_t O_PQF   = O_XS + (size_t)NTOK * DM * 2;
constexpr size_t O_PQFC  = O_PQF + (size_t)NBATCH * 256 * LSEQ * 2;
static_assert(O_PQFC + (size_t)NBATCH * 256 * LCTX * 2 <= O_H, "folded fnet operands fit");
constexpr size_t O_FLAG  = O_QCNT + 24576;
constexpr size_t O_XG8   = O_M;
constexpr size_t O_HID   = O_PM;
static_assert((size_t)NEXP * EROWS * FF * 2 <= O_PQT - O_PM, "hidden alias fits");
static_assert((size_t)NEXP * EROWS * DM * 2 <= (size_t)NTOK * DM * 4, "Y fits in macc region");
static_assert(O_END + (size_t)NTOK * DM + (size_t)NLAYER * 3072 * DM <= (size_t)2147483648ull, "workspace fits 2 GiB");

struct Prm {
    const float *x, *c, *ctx, *c_ctx, *w_mod, *b_mod, *norm1_g, *norm2_g, *w_in, *q_gain, *k_gain, *hy_sw, *hy_sb,
        *hy_w1, *hy_b1, *hy_w2, *hy_b2, *hy_w3, *hy_freq, *hy_bias, *w_branch, *w_out, *w_router, *w_gate, *w_up, *w_down, *final_g;
    float* out;
    unsigned char* ws;
};

__device__ __forceinline__ unsigned f2bf(float f) { unsigned u = __float_as_uint(f); return (u + 0x7fffu + ((u >> 16) & 1u)) >> 16; }
typedef float f32x2_t __attribute__((ext_vector_type(2))); typedef __bf16 bf16x2_t __attribute__((ext_vector_type(2)));
__device__ __forceinline__ unsigned pk2(float lo, float hi) { const f32x2_t v = {lo, hi}; const bf16x2_t b = __builtin_convertvector(v, bf16x2_t); return __builtin_bit_cast(unsigned, b); }
__device__ __forceinline__ float bf2f(bf16_t b) { return __uint_as_float((unsigned)b << 16); }
__device__ __forceinline__ float bflo(unsigned w) { return __uint_as_float(w << 16); }
__device__ __forceinline__ float bfhi(unsigned w) { return __uint_as_float(w & 0xffff0000u); }
__device__ __forceinline__ float clamp8(float x) { return __builtin_amdgcn_fmed3f(x, -448.0f, 448.0f); }
__device__ __forceinline__ unsigned pk4_fp8(float a, float b, float c, float d) { int w = 0; w = __builtin_amdgcn_cvt_pk_fp8_f32(clamp8(a), clamp8(b), w, false); w = __builtin_amdgcn_cvt_pk_fp8_f32(clamp8(c), clamp8(d), w, true); return (unsigned)w; }
constexpr float Y8S = 16.0f, Y8I = 1.0f / 16.0f;
constexpr float W8S = 64.0f, W8I = 1.0f / 64.0f, H8S = 8.0f;
__device__ __forceinline__ float wave_sum(float v) {
#pragma unroll
    for (int o = 32; o >= 1; o >>= 1) v += __shfl_xor(v, o);
    return v;
}
__device__ __forceinline__ float sigmoidf_(float v) { return __builtin_amdgcn_rcpf(1.0f + __expf(-v)); }

__device__ __forceinline__ int tid_() { int t = threadIdx.x; asm volatile("" : "+v"(t)); return t; }
__device__ __forceinline__ int bid_() { int b = blockIdx.x; asm volatile("" : "+s"(b)); return b; }
__device__ __forceinline__ int nblk_() { int g = gridDim.x; asm volatile("" : "+s"(g)); return g; }
constexpr int BM = 256, BK = 64, HALF = 128, HTB = HALF * BK * 2;
__device__ __forceinline__ int lds_byte(int r, int c) { const int st = (r >> 4) * 2 + (c >> 5), rr = r & 15, cc = c & 31, ob = rr * 64 + cc * 2; return st * 1024 + (ob ^ (((ob >> 9) & 1) << 5)); }
__device__ __forceinline__ void stage_rc(int b, int& R, int& C) { const int st = b / 1024, sb = b % 1024, swz = sb ^ (((sb >> 9) & 1) << 5); R = (st >> 1) * 16 + swz / 64; C = (st & 1) * 32 + (swz % 64) / 2; }

struct GU {
    const bf16_t* A;
    const bf16_t* B;
    const int* gidx;
    int lda, ldb, nt;
    int i0, i1, i2, i3;
};

template <class Epi, class Sched>
__device__ __forceinline__ void gemm_simple(LAS unsigned char* lds, const Sched& S, const Epi& E) {
    const int tid = tid_(), wid = tid >> 6, lane = tid & 63, wr = wid >> 2, wc = wid & 3, fr = lane & 15, fq = lane >> 4;
    int R[2], C[2];
#pragma unroll
    for (int i = 0; i < 2; ++i) stage_rc(tid * 16 + i * 8192, R[i], C[i]);
    const int aoff = lds_byte(wr * 64 + fr, fq * 8), boff = lds_byte(wc * 32 + fr, fq * 8);
    GU u;
    for (int ui = 0; S.next(ui, u); ++ui) {
        f32x4 acc[2][2][4][2];
#pragma unroll
        for (int a = 0; a < 2; ++a)
#pragma unroll
            for (int b = 0; b < 2; ++b)
#pragma unroll
                for (int m = 0; m < 4; ++m)
#pragma unroll
                    for (int n = 0; n < 2; ++n) acc[a][b][m][n] = (f32x4){0.f, 0.f, 0.f, 0.f};
        size_t arow[2][2];
#pragma unroll
        for (int h = 0; h < 2; ++h)
#pragma unroll
            for (int i = 0; i < 2; ++i) { const int row = h * HALF + R[i]; arow[h][i] = (size_t)(u.gidx ? u.gidx[row] : row) * u.lda + C[i]; }
        for (int kt = 0; kt < u.nt; ++kt) {
            u32x4 va[2][2], vb[2][2];
#pragma unroll
            for (int h = 0; h < 2; ++h)
#pragma unroll
                for (int i = 0; i < 2; ++i) {
                    va[h][i] = *(const u32x4*)(u.A + arow[h][i] + kt * BK);
                    vb[h][i] = *(const u32x4*)(u.B + (size_t)(h * HALF + R[i]) * u.ldb + C[i] + kt * BK);
                }
            __syncthreads();
#pragma unroll
            for (int h = 0; h < 2; ++h)
#pragma unroll
                for (int i = 0; i < 2; ++i) {
                    *(LAS u32x4*)(lds + h * HTB + tid * 16 + i * 8192) = va[h][i];
                    *(LAS u32x4*)(lds + (2 + h) * HTB + tid * 16 + i * 8192) = vb[h][i];
                }
            __syncthreads();
#pragma unroll
            for (int ai = 0; ai < 2; ++ai) {
                bf16x8 At[4][2];
#pragma unroll
                for (int m = 0; m < 4; ++m)
#pragma unroll
                    for (int k = 0; k < 2; ++k) At[m][k] = *(const LAS bf16x8*)(lds + ai * HTB + aoff + m * 2048 + k * 1024);
#pragma unroll
                for (int bj = 0; bj < 2; ++bj) {
                    bf16x8 Bf[2][2];
#pragma unroll
                    for (int n = 0; n < 2; ++n)
#pragma unroll
                        for (int k = 0; k < 2; ++k) Bf[n][k] = *(const LAS bf16x8*)(lds + (2 + bj) * HTB + boff + n * 2048 + k * 1024);
#pragma unroll
                    for (int m = 0; m < 4; ++m)
#pragma unroll
                        for (int n = 0; n < 2; ++n)
#pragma unroll
                            for (int k = 0; k < 2; ++k)
                                acc[ai][bj][m][n] = __builtin_amdgcn_mfma_f32_16x16x32_bf16(Bf[n][k], At[m][k], acc[ai][bj][m][n], 0, 0, 0);
                }
            }
        }
        E(acc, u, wr, wc, fr, fq);
        __syncthreads();
    }
}


__device__ __forceinline__ int brow_of(int R) { return 64 * (R >> 5) + 16 * ((R >> 2) & 3) + 4 * ((R >> 4) & 1) + (R & 3); }
template <bool GATHER, int MID = 0, bool FP8 = false, class Epi, class Sched>
__device__ __forceinline__ void gemm_fast(LAS unsigned char* lds, const Sched& S, const Epi& E, const int lda, const int ldb, const int nt) {
    const int tid = tid_(), wid = __builtin_amdgcn_readfirstlane(tid >> 6), lane = tid & 63, wr = wid >> 2, wc = wid & 3, fr = lane & 15, fq = lane >> 4;
    int R[2], C[2];
#pragma unroll
    for (int i = 0; i < 2; ++i) stage_rc(tid * 16 + i * 8192, R[i], C[i]);
    unsigned offA[2][2], noffA[2][2], offB[2];
#pragma unroll
    for (int i = 0; i < 2; ++i) { offB[i] = (unsigned)(brow_of(R[i]) * ldb + C[i]) * 2u;
#pragma unroll
        for (int h = 0; h < 2; ++h) { offA[h][i] = (unsigned)((h * HALF + R[i]) * lda + C[i]) * 2u; noffA[h][i] = offA[h][i]; } }
    const size_t kstep = (size_t)(BK * 2);
    const size_t hstepB = (size_t)8 * ldb * 2;
    const size_t hstepA = GATHER ? 0 : (size_t)HALF * lda * 2;
#define OFA1 (GATHER ? offA[1] : offA[0])
#define O2A1 (GATHER ? o2[1] : o2[0])
    const unsigned ldsw = (unsigned)wid * 1024u;
    const int aoff = lds_byte(wr * 64 + fr, fq * 8), boff = lds_byte(wc * 32 + fr, fq * 8);
#define PG8_SA(b, h) (((b) * 2 + (h)) * HTB)
#define PG8_SB(b, h) ((4 + (b) * 2 + (h)) * HTB)
#define PG8_STAGE(bufoff, gbase, voff) do { _Pragma("unroll") for (int _i = 0; _i < 2; ++_i) \
        __builtin_amdgcn_global_load_lds((const unsigned*)((const char*)(gbase) + (voff)[_i]), (LAS unsigned*)(lds + (bufoff) + ldsw + _i * 8192), 16, 0, 0); } while (0)
#define PG8_LDA(dst, b, h) do { _Pragma("unroll") for (int m = 0; m < 4; ++m) _Pragma("unroll") for (int k = 0; k < 2; ++k) dst[m][k] = *(const LAS bf16x8*)(lds + PG8_SA(b, h) + aoff + m * 2048 + k * 1024); } while (0)
#define PG8_LDB(dst, b, h) do { _Pragma("unroll") for (int n = 0; n < 2; ++n) _Pragma("unroll") for (int k = 0; k < 2; ++k) dst[n][k] = *(const LAS bf16x8*)(lds + PG8_SB(b, h) + boff + n * 2048 + k * 1024); } while (0)
#define PG8_CAT(x, y) __builtin_shufflevector(__builtin_bit_cast(i32x4, x), __builtin_bit_cast(i32x4, y), 0, 1, 2, 3, 4, 5, 6, 7)
#define PG8_MMA(ai, bj, At, Bt, Z) do { __builtin_amdgcn_s_setprio(1); _Pragma("unroll") for (int m = 0; m < 4; ++m) _Pragma("unroll") for (int n = 0; n < 2; ++n) { \
        if constexpr (FP8) { const i32x8 bo_ = PG8_CAT(Bt[n][0], Bt[n][1]), ao_ = PG8_CAT(At[m][0], At[m][1]); \
            if (Z) asm volatile("v_mfma_scale_f32_16x16x128_f8f6f4 %0, %1, %2, 0, %3, %3 op_sel_hi:[0,0,0]" : "=&v"(acc[ai][bj][m][n]) : "v"(bo_), "v"(ao_), "v"(one8)); \
            else asm volatile("v_mfma_scale_f32_16x16x128_f8f6f4 %0, %1, %2, %0, %3, %3 op_sel_hi:[0,0,0]" : "+v"(acc[ai][bj][m][n]) : "v"(bo_), "v"(ao_), "v"(one8)); } \
        else { if (Z) acc[ai][bj][m][n] = __builtin_amdgcn_mfma_f32_16x16x32_bf16(Bt[n][0], At[m][0], (f32x4){0.f, 0.f, 0.f, 0.f}, 0, 0, 0); \
               else acc[ai][bj][m][n] = __builtin_amdgcn_mfma_f32_16x16x32_bf16(Bt[n][0], At[m][0], acc[ai][bj][m][n], 0, 0, 0); \
               acc[ai][bj][m][n] = __builtin_amdgcn_mfma_f32_16x16x32_bf16(Bt[n][1], At[m][1], acc[ai][bj][m][n], 0, 0, 0); } } __builtin_amdgcn_s_setprio(0); } while (0)
#define PG8_WAIT_V(n) asm volatile("s_waitcnt vmcnt(" #n ")" ::: "memory")
#define PG8_WAIT_L(n) asm volatile("s_waitcnt lgkmcnt(" #n ")" ::: "memory")
#define PG8_BAR __builtin_amdgcn_s_barrier()
#define PG8_SCHED __builtin_amdgcn_sched_barrier(0)
#define PG8_KITER(t, Z) do { \
            const bool last = (t == nt - 2); \
            if constexpr (MID != 0) { if (t == 8 || t == 12) E.mid(acc, cur, t, wr, wc, fr, fq); } \
            const char* a1 = cA + (size_t)(t + 1) * kstep; \
            const char* a2 = last ? nA : cA + (size_t)(t + 2) * kstep; const char* b2 = last ? nB : cB + (size_t)(t + 2) * kstep; \
            const char* a3 = a2 + kstep; const char* b3 = b2 + kstep; \
            unsigned o2[2][2]; \
_Pragma("unroll") \
            for (int h = 0; h < 2; ++h) \
_Pragma("unroll") \
                for (int i = 0; i < 2; ++i) o2[h][i] = (GATHER && last) ? noffA[h][i] : offA[h][i]; \
            PG8_LDB(B0, 0, 0); PG8_SCHED; PG8_LDA(At, 0, 0); PG8_STAGE(PG8_SA(1, 1), a1 + hstepA, OFA1); \
            PG8_WAIT_L(8); PG8_BAR; PG8_WAIT_L(0); PG8_MMA(0, 0, At, B0, Z); PG8_BAR; PG8_SCHED; \
            PG8_LDB(B1, 0, 1); PG8_STAGE(PG8_SB(0, 0), b2, offB); \
            PG8_BAR; PG8_WAIT_L(0); PG8_MMA(0, 1, At, B1, Z); PG8_BAR; \
            PG8_LDA(At, 0, 1); PG8_STAGE(PG8_SA(0, 0), a2, o2[0]); \
            PG8_BAR; PG8_WAIT_L(0); PG8_MMA(1, 0, At, B0, Z); PG8_BAR; PG8_SCHED; \
            PG8_STAGE(PG8_SB(0, 1), b2 + hstepB, offB); \
            PG8_WAIT_V(6); PG8_BAR; PG8_MMA(1, 1, At, B1, Z); PG8_BAR; \
            PG8_LDB(B0, 1, 0); PG8_SCHED; PG8_LDA(At, 1, 0); PG8_STAGE(PG8_SA(0, 1), a2 + hstepA, O2A1); \
            PG8_WAIT_L(8); PG8_BAR; PG8_WAIT_L(0); PG8_MMA(0, 0, At, B0, 0); PG8_BAR; PG8_SCHED; \
            PG8_LDB(B1, 1, 1); PG8_STAGE(PG8_SB(1, 0), b3, offB); \
            PG8_BAR; PG8_WAIT_L(0); PG8_MMA(0, 1, At, B1, 0); PG8_BAR; \
            PG8_LDA(At, 1, 1); PG8_STAGE(PG8_SA(1, 0), a3, o2[0]); \
            PG8_BAR; PG8_WAIT_L(0); PG8_MMA(1, 0, At, B0, 0); PG8_BAR; PG8_SCHED; \
            PG8_STAGE(PG8_SB(1, 1), b3 + hstepB, offB); \
            PG8_WAIT_V(6); PG8_BAR; PG8_MMA(1, 1, At, B1, 0); PG8_BAR; \
        } while (0)
    GU cur, nxt; int ui = 0;
    if (!S.next(0, cur)) return;
    if (GATHER) {
#pragma unroll
        for (int h = 0; h < 2; ++h)
#pragma unroll
            for (int i = 0; i < 2; ++i) offA[h][i] = (unsigned)(cur.gidx[h * HALF + R[i]] * lda + C[i]) * 2u;
    }
    f32x4 acc[2][2][4][2];
    if constexpr (!FP8) {
#pragma unroll
    for (int a = 0; a < 2; ++a)
#pragma unroll
        for (int b = 0; b < 2; ++b)
#pragma unroll
            for (int m = 0; m < 4; ++m)
#pragma unroll
                for (int n = 0; n < 2; ++n) acc[a][b][m][n] = (f32x4){0.f, 0.f, 0.f, 0.f};
    }
    bf16x8 At[4][2], B0[2][2], B1[2][2];
    const unsigned one8 = 0x7f7f7f7fu;
    const char* cA = (const char*)cur.A; const char* cB = (const char*)cur.B;
    __syncthreads();
    PG8_STAGE(PG8_SB(0, 0), cB, offB); PG8_STAGE(PG8_SA(0, 0), cA, offA[0]); PG8_STAGE(PG8_SB(0, 1), cB + hstepB, offB); PG8_STAGE(PG8_SA(0, 1), cA + hstepA, OFA1);
    if (wr == 1) PG8_BAR;
    PG8_WAIT_V(4); PG8_BAR;
    PG8_STAGE(PG8_SB(1, 0), cB + kstep, offB); PG8_STAGE(PG8_SA(1, 0), cA + kstep, offA[0]); PG8_STAGE(PG8_SB(1, 1), cB + hstepB + kstep, offB);
    PG8_WAIT_V(6); PG8_BAR;
    for (;;) {
        const bool has_next = S.next(ui + 1, nxt);
        const char* nA = has_next ? (const char*)nxt.A : cA; const char* nB = has_next ? (const char*)nxt.B : cB;
        if (GATHER) {
#pragma unroll
            for (int h = 0; h < 2; ++h)
#pragma unroll
                for (int i = 0; i < 2; ++i) noffA[h][i] = has_next ? (unsigned)(nxt.gidx[h * HALF + R[i]] * lda + C[i]) * 2u : offA[h][i];
        }
        if constexpr (FP8) { PG8_KITER(0, 1); for (int t = 2; t < nt; t += 2) PG8_KITER(t, 0); }
        else { for (int t = 0; t < nt; t += 2) PG8_KITER(t, 0); }
        if constexpr (FP8) asm volatile("s_nop 15\n\ts_nop 15" ::: "memory");
        E(acc, cur, wr, wc, fr, fq);
        if (!has_next) break;
        if constexpr (!FP8) {
#pragma unroll
        for (int a = 0; a < 2; ++a)
#pragma unroll
            for (int b = 0; b < 2; ++b)
#pragma unroll
                for (int m = 0; m < 4; ++m)
#pragma unroll
                    for (int n = 0; n < 2; ++n) acc[a][b][m][n] = (f32x4){0.f, 0.f, 0.f, 0.f};
        }
        cur = nxt; cA = nA; cB = nB; ++ui;
        if (GATHER) {
#pragma unroll
            for (int h = 0; h < 2; ++h)
#pragma unroll
                for (int i = 0; i < 2; ++i) offA[h][i] = noffA[h][i];
        }
    }
    PG8_WAIT_V(0);
    if (wr == 0) PG8_BAR;
    PG8_BAR;
#undef OFA1
#undef O2A1
#undef PG8_SA
#undef PG8_SB
#undef PG8_STAGE
#undef PG8_LDA
#undef PG8_LDB
#undef PG8_MMA
#undef PG8_KITER
#undef PG8_CAT
#undef PG8_WAIT_V
#undef PG8_WAIT_L
#undef PG8_BAR
#undef PG8_SCHED
}

#define EPI_ROWS(...)                                                                              \
    _Pragma("unroll") for (int ai = 0; ai < 2; ++ai) _Pragma("unroll") for (int m = 0; m < 4; ++m) { \
        const int row = ai * HALF + wr * 64 + m * 16 + fr; __VA_ARGS__ }
#define EPI_COLS(...) _Pragma("unroll") for (int bj = 0; bj < 2; ++bj) _Pragma("unroll") for (int n = 0; n < 2; ++n) { const int q = bj * 2 + n; const int col = wc * 64 + fq * 16 + bj * 8 + n * 4; __VA_ARGS__ }
#define EPI_PK8(A0, A1) ((u32x4){pk2((A0)[0], (A0)[1]), pk2((A0)[2], (A0)[3]), pk2((A1)[0], (A1)[1]), pk2((A1)[2], (A1)[3])})
__device__ __forceinline__ void unpk8(const u32x4 w, float (&f)[8]) { f[0] = bflo(w.x); f[1] = bfhi(w.x); f[2] = bflo(w.y); f[3] = bfhi(w.y); f[4] = bflo(w.z); f[5] = bfhi(w.z); f[6] = bflo(w.w); f[7] = bfhi(w.w); }

struct EpiPm {
    bf16_t *PM, *QP, *KP; const float *qg, *kg, *rope;
    __device__ __forceinline__ void operator()(const f32x4 (&acc)[2][2][4][2], const GU& u, int wr, int wc, int fr, int fq) const {
        const int r0 = u.i0 * BM, pn = u.i1;
        if (pn == 2 && wc >= 2) {
            bf16_t* ob = PM + (size_t)r0 * PMW + 640 + (wc - 2) * 64; unsigned lo = (unsigned)((wr * 64 + fr) * PMW + 16 * fq); asm volatile("" : "+v"(lo));
            EPI_ROWS({
_Pragma("unroll")
                for (int bj = 0; bj < 2; ++bj) { const f32x4 a0 = acc[ai][bj][m][0] * W8I, a1 = acc[ai][bj][m][1] * W8I; *(u32x4*)(ob + lo + (unsigned)((ai * HALF + m * 16) * PMW) + bj * 8) = EPI_PK8(a0, a1); } })
            return; }
        const bool isq = pn < 2; const float* gn = isq ? qg : kg; const float osc = isq ? 0.125f * 1.4426950408889634f : 1.0f;
        f32x4 g[4];
        EPI_COLS({ g[q] = *(const f32x4*)(gn + 16 * fq + bj * 8 + n * 4) * osc; })
        const int tq = (u.i0 % 9) * 256; const bool isctx = tq >= LSEQ;
        bf16_t* ob = isq ? QP + (size_t)r0 * 512 + (pn * 4 + wc) * 64 + 16 * fq : KP + (size_t)r0 * 128 + wc * 64 + 16 * fq; const int opitch = isq ? 512 : 128;
        EPI_ROWS({ float ss = 0.f;
            EPI_COLS({ const f32x4 v = acc[ai][bj][m][n]; ss += v[0] * v[0] + v[1] * v[1] + v[2] * v[2] + v[3] * v[3]; })
            ss += __shfl_xor(ss, 16); ss += __shfl_xor(ss, 32);
            const float rstd = rsqrtf(ss * (W8I * W8I / 64.0f) + EPS) * W8I;
            f32x4 o[4];
            EPI_COLS({ f32x4 v = acc[ai][bj][m][n] * rstd * g[q];
                if (!isctx) { const f32x4 cs = *(const f32x4*)(rope + ((size_t)(tq + row) * 32 + 8 * fq + 4 * bj + 2 * n) * 2);
                    const float a0 = v[0], b0 = v[1], a1 = v[2], b1 = v[3]; v[0] = a0 * cs[0] - b0 * cs[1]; v[1] = a0 * cs[1] + b0 * cs[0]; v[2] = a1 * cs[2] - b1 * cs[3]; v[3] = a1 * cs[3] + b1 * cs[2]; }
                o[q] = v; })
            *(u32x4*)(ob + (size_t)row * opitch) = EPI_PK8(o[0], o[1]); *(u32x4*)(ob + (size_t)row * opitch + 8) = EPI_PK8(o[2], o[3]); })
    }
};
typedef float f32x2g __attribute__((ext_vector_type(2)));
__device__ __forceinline__ void unpk4_f8(unsigned w, float (&f)[4]) { const f32x2g lo = __builtin_amdgcn_cvt_pk_f32_fp8((int)w, false), hi = __builtin_amdgcn_cvt_pk_f32_fp8((int)w, true); f[0] = lo[0]; f[1] = lo[1]; f[2] = hi[0]; f[3] = hi[1]; }
constexpr int PMG = 768 * 2, PMB = PMW * 2;
struct EpiGate {
    bf16_t* PM;
    __device__ __forceinline__ void operator()(const f32x4 (&acc)[2][2][4][2], const GU& u, int wr, int wc, int fr, int fq) const {
        unsigned char* ob = (unsigned char*)PM + (size_t)(u.i0 * BM) * PMB + PMG + u.i1 * BM; unsigned lo = (unsigned)((wr * 64 + fr) * PMB + wc * 64 + 16 * fq); asm volatile("" : "+v"(lo));
        EPI_ROWS({ unsigned pk[4];
_Pragma("unroll")
            for (int bj = 0; bj < 2; ++bj)
_Pragma("unroll")
                for (int n = 0; n < 2; ++n) { f32x4 w;
_Pragma("unroll")
                    for (int j = 0; j < 4; ++j) w[j] = __builtin_amdgcn_exp2f(acc[ai][bj][m][n][j] * (-1.4426950408889634f * W8I));
                    pk[bj * 2 + n] = pk4_fp8(w[0], w[1], w[2], w[3]); }
            *(u32x4*)(ob + lo + (unsigned)((ai * HALF + m * 16) * PMB)) = (u32x4){pk[0], pk[1], pk[2], pk[3]}; })
    }
};
struct EpiSw {
    bf16_t *HYT, *HYTC, *PQT, *PQTC;
    __device__ __forceinline__ void operator()(const f32x4 (&acc)[2][2][4][2], const GU& u, int wr, int wc, int fr, int fq) const {
        const int pm = u.i0, pn = u.i1, b = pn / 9, j = pn % 9; const bool isctx = (j == 8);
        bf16_t* base; unsigned rs;
        if (pm < 3) { if (isctx) { base = HYTC + ((size_t)pm * 256 * NBATCH + b) * LCTX; rs = NBATCH * LCTX; } else { base = HYT + ((size_t)pm * 256 * NBATCH + b) * LSEQ + j * 256; rs = NBATCH * LSEQ; } }
        else { const int q = pm - 3; if (isctx) { base = PQTC + (size_t)b * 256 * 512 + q * 256; rs = 512; } else { base = PQT + (size_t)b * 256 * 4096 + q * 2048 + j * 256; rs = 4096; } }
        unsigned lo = (unsigned)(wr * 64 + fr) * rs + (unsigned)(wc * 64 + 16 * fq); asm volatile("" : "+v"(lo));
        EPI_ROWS({
_Pragma("unroll")
            for (int bj = 0; bj < 2; ++bj) *(u32x4*)(base + lo + (unsigned)(ai * HALF + m * 16) * rs + bj * 8) = EPI_PK8(acc[ai][bj][m][0], acc[ai][bj][m][1]); })
    }
};
struct EpiBf {
    bf16_t* O; int ld; float scale;
    __device__ __forceinline__ void operator()(const f32x4 (&acc)[2][2][4][2], const GU& u, int wr, int wc, int fr, int fq) const {
        bf16_t* ob = O + (size_t)u.i0 * ld + u.i1; unsigned lo = (unsigned)((wr * 64 + fr) * ld + wc * 64 + 16 * fq); asm volatile("" : "+v"(lo));
        EPI_ROWS({
_Pragma("unroll")
            for (int bj = 0; bj < 2; ++bj) { const f32x4 a0 = acc[ai][bj][m][0] * scale, a1 = acc[ai][bj][m][1] * scale; *(u32x4*)(ob + lo + (unsigned)((ai * HALF + m * 16) * ld) + bj * 8) = EPI_PK8(a0, a1); } })
    }
};
struct EpiF8 {
    unsigned char* O; int ld; float scale;
    __device__ __forceinline__ void operator()(const f32x4 (&acc)[2][2][4][2], const GU& u, int wr, int wc, int fr, int fq) const {
        unsigned char* ob = O + (size_t)u.i0 * ld + u.i1; unsigned lo = (unsigned)((wr * 64 + fr) * ld + wc * 64 + 16 * fq); asm volatile("" : "+v"(lo));
        EPI_ROWS({ unsigned pk[4];
_Pragma("unroll")
            for (int bj = 0; bj < 2; ++bj) { const f32x4 a0 = acc[ai][bj][m][0] * scale, a1 = acc[ai][bj][m][1] * scale;
                pk[bj * 2] = pk4_fp8(a0[0], a0[1], a0[2], a0[3]); pk[bj * 2 + 1] = pk4_fp8(a1[0], a1[1], a1[2], a1[3]); }
            *(u32x4*)(ob + lo + (unsigned)((ai * HALF + m * 16) * ld)) = (u32x4){pk[0], pk[1], pk[2], pk[3]}; })
    }
};
struct EpiMerge {
    const bf16_t* PM; bf16_t* M;
    __device__ __forceinline__ void mid(f32x4 (&acc)[2][2][4][2], const GU& u, int t, int wr, int wc, int fr, int fq) const {
        const unsigned char* gp = (const unsigned char*)PM + (size_t)(u.i0 * BM) * PMB + PMG + ((t == 8) ? 0 : 1024) + u.i1 * BM;
        unsigned lo = (unsigned)((wr * 64 + fr) * PMB + wc * 64 + 16 * fq); asm volatile("" : "+v"(lo));
#pragma unroll
        for (int ai = 0; ai < 2; ++ai) {
            u32x4 ga[4], gb[4];
#pragma unroll
            for (int m = 0; m < 4; ++m) { const unsigned ro = lo + (unsigned)((ai * HALF + m * 16) * PMB); ga[m] = *(const u32x4*)(gp + ro); gb[m] = *(const u32x4*)(gp + ro + 1024); }
#pragma unroll
            for (int m = 0; m < 4; ++m)
#pragma unroll
                for (int bj = 0; bj < 2; ++bj)
#pragma unroll
                    for (int n = 0; n < 2; ++n) { float a[4], b[4]; unpk4_f8(ga[m][bj * 2 + n], a); unpk4_f8(gb[m][bj * 2 + n], b);
                        f32x4 w = acc[ai][bj][m][n];
#pragma unroll
                        for (int j = 0; j < 4; ++j) w[j] *= (1.0f + b[j]) * __builtin_amdgcn_rcpf(1.0f + a[j]);
                        acc[ai][bj][m][n] = w; }
        }
    }
    __device__ __forceinline__ void operator()(const f32x4 (&acc)[2][2][4][2], const GU& u, int wr, int wc, int fr, int fq) const {
        const unsigned char* gp = (const unsigned char*)PM + (size_t)(u.i0 * BM) * PMB + PMG + 2048 + u.i1 * BM; bf16_t* mp = M + (size_t)(u.i0 * BM) * DM + u.i1 * BM;
        unsigned lo = (unsigned)((wr * 64 + fr) * PMB + wc * 64 + 16 * fq), mo = (unsigned)((wr * 64 + fr) * DM + wc * 64 + 16 * fq); asm volatile("" : "+v"(lo), "+v"(mo));
#pragma unroll
        for (int ai = 0; ai < 2; ++ai) {
            u32x4 g[4];
#pragma unroll
            for (int m = 0; m < 4; ++m) g[m] = *(const u32x4*)(gp + lo + (unsigned)((ai * HALF + m * 16) * PMB));
#pragma unroll
            for (int m = 0; m < 4; ++m)
#pragma unroll
                for (int bj = 0; bj < 2; ++bj) { float a0[4], a1[4]; unpk4_f8(g[m][bj * 2], a0); unpk4_f8(g[m][bj * 2 + 1], a1); f32x4 w0 = acc[ai][bj][m][0], w1 = acc[ai][bj][m][1];
#pragma unroll
                    for (int j = 0; j < 4; ++j) { w0[j] *= __builtin_amdgcn_rcpf(1.0f + a0[j]); w1[j] *= __builtin_amdgcn_rcpf(1.0f + a1[j]); }
                    *(u32x4*)(mp + mo + (unsigned)((ai * HALF + m * 16) * DM) + bj * 8) = EPI_PK8(w0, w1); }
        }
    }
};
struct EpiY {
    bf16_t* O;
    __device__ __forceinline__ void operator()(const f32x4 (&acc)[2][2][4][2], const GU& u, int wr, int wc, int fr, int fq) const {
        bf16_t* ob = O + (size_t)(u.i0 * BM) * DM + u.i1 * BM; unsigned lo = (unsigned)((wr * 64 + fr) * DM + wc * 64 + 16 * fq); asm volatile("" : "+v"(lo));
        EPI_ROWS({
_Pragma("unroll")
            for (int bj = 0; bj < 2; ++bj) *(u32x4*)(ob + lo + (unsigned)((ai * HALF + m * 16) * DM) + bj * 8) = EPI_PK8(acc[ai][bj][m][0], acc[ai][bj][m][1]); })
    }
};
struct EpiRes {
    float* XS; const float* modl; int goff;
    __device__ __forceinline__ void operator()(const f32x4 (&acc)[2][2][4][2], const GU& u, int wr, int wc, int fr, int fq) const {
        const int c0 = u.i1 * BM; const int pn9 = u.i0 % 9, b = u.i0 / 9; const int mrow = (pn9 == 8) ? 16 : b;
        const float* gp = modl + (size_t)mrow * 6144 + goff + c0; f32x4 g[4];
        EPI_COLS({ g[q] = *(const f32x4*)(gp + col); })
        float* xb = XS + (size_t)(u.i0 * BM) * DM + c0; unsigned xo = (unsigned)((wr * 64 + fr) * DM + wc * 64 + 16 * fq); asm volatile("" : "+v"(xo));
#pragma unroll
        for (int ai = 0; ai < 2; ++ai) {
            f32x4 o[4][4];
#pragma unroll
            for (int m = 0; m < 4; ++m)
#pragma unroll
                for (int q = 0; q < 4; ++q) o[m][q] = *(const f32x4*)(xb + xo + (unsigned)((ai * HALF + m * 16) * DM) + q * 4);
#pragma unroll
            for (int m = 0; m < 4; ++m)
#pragma unroll
                for (int q = 0; q < 4; ++q) *(f32x4*)(xb + xo + (unsigned)((ai * HALF + m * 16) * DM) + q * 4) = o[m][q] + g[q] * acc[ai][q >> 1][m][q & 1];
        }
    }
};
struct EpiGlu {
    unsigned char* HID;
    __device__ __forceinline__ void operator()(const f32x4 (&acc)[2][2][4][2], const GU& u, int wr, int wc, int fr, int fq) const {
        unsigned char* hb = HID + (size_t)u.i0 * FF + u.i1; unsigned lo = (unsigned)((wr * 64 + fr) * FF + wc * 32 + 8 * fq); asm volatile("" : "+v"(lo));
        EPI_ROWS({ unsigned pk[2];
_Pragma("unroll")
            for (int n = 0; n < 2; ++n) { const f32x4 ga = acc[ai][0][m][n], ua = acc[ai][1][m][n]; f32x4 w;
_Pragma("unroll")
                for (int j = 0; j < 4; ++j) w[j] = (ga[j] * ua[j]) * (W8I * W8I * H8S) * __builtin_amdgcn_rcpf(1.0f + __builtin_amdgcn_exp2f(ga[j] * (-1.4426950408889634f * W8I)));
                pk[n] = pk4_fp8(w[0], w[1], w[2], w[3]); }
            *(u32x2*)(hb + lo + (unsigned)((ai * HALF + m * 16) * FF)) = (u32x2){pk[0], pk[1]}; })
    }
};

__device__ __forceinline__ bool tile_order(int L, int nM, int nN, int& pm, int& pn) {
    const int nwg = nM * nN; if (L >= nwg) return false;
    int wgid = L; { const int q = nwg / 8, r = nwg % 8, xcd = wgid % 8, off = wgid / 8; wgid = (xcd < r ? xcd * (q + 1) : r * (q + 1) + (xcd - r) * q) + off; }
    const int nig = 8 * nN, gid = wgid / nig, fm = gid * 8, gsz = (nM - fm) < 8 ? (nM - fm) : 8;
    pm = fm + ((wgid % nig) % gsz); pn = (wgid % nig) / gsz; return true;
}

struct SchedG1 {
    const bf16_t *H, *WM, *WS; int g, c;
    __device__ __forceinline__ bool next(int i, GU& u) const {
        const int L = i * g + c; if (L >= 144 * 20) return false;
        const int pn_all = L % 20, pmt = L / 20;
        u.gidx = nullptr; u.lda = DM; u.ldb = DM; u.nt = 16; u.i2 = 0; u.i3 = 0;
        if (pn_all < 15) { u.A = H + (size_t)pmt * BM * DM; u.B = WM + (size_t)pn_all * BM * DM; u.i0 = pmt; u.i1 = pn_all; u.i2 = 0; }
        else { u.A = WS + (size_t)(pn_all - 15) * BM * DM; u.B = H + (size_t)pmt * BM * DM; u.i0 = pn_all - 15; u.i1 = pmt; u.i2 = 1; }
        return true;
    }
};
struct SchedFnL {
    const bf16_t *DFTM, *PQT; int g, c;
    __device__ __forceinline__ bool next(int i, GU& u) const {
        const int L = i * g + c; if (L >= 128) return false;
        const int b = L >> 3, pm = L & 7; u.gidx = nullptr; u.i2 = 0; u.i3 = 0; u.i1 = 768; u.lda = 4096; u.ldb = 4096; u.nt = 64;
        u.A = DFTM + (size_t)pm * BM * 4096; u.B = PQT + (size_t)b * 256 * 4096; u.i0 = b * TPB + pm * 256; return true; }
};
struct SchedFnC {
    const bf16_t *DFTC, *PQTC; int g, c;
    __device__ __forceinline__ bool next(int i, GU& u) const {
        const int L = i * g + c; if (L >= 16) return false;
        u.gidx = nullptr; u.i2 = 0; u.i3 = 0; u.i1 = 768; u.lda = 512; u.ldb = 512; u.nt = 8;
        u.A = DFTC; u.B = PQTC + (size_t)L * 256 * 512; u.i0 = L * TPB + LSEQ; return true; }
};
struct SchedSq {
    const bf16_t *A, *B; int g, c, lat, p0, np, rev;
    __device__ __forceinline__ bool next(int i, GU& u) const {
        int pm, pn; if (!tile_order(i * g + (rev ? g - 1 - c : c), np, 4, pm, pn)) return false;
        pm += p0; if (lat) pm = (pm >> 3) * 9 + (pm & 7);
        u.gidx = nullptr; u.lda = DM; u.ldb = DM; u.nt = 16; u.A = A + (size_t)pm * BM * DM; u.B = B + (size_t)pn * BM * DM; u.i0 = pm; u.i1 = pn; u.i2 = 0; u.i3 = 0;
        return true;
    }
};
struct SchedUp {
    const bf16_t *H, *WGU; const int* IDX; int g, c, nmt;
    __device__ __forceinline__ bool next(int i, GU& u) const {
        int rm, pn; if (!tile_order(i * g + c, 16, NEXP * nmt, pn, rm)) return false;
        const int mt = rm % nmt, e = rm / nmt;
        u.A = H + (size_t)(e * EROWS + mt * 256) * 512; u.gidx = nullptr; u.lda = 512; u.B = WGU + ((size_t)e * 4096 + pn * 256) * 512; u.ldb = 512; u.nt = 8; u.i0 = e * EROWS + mt * 256; u.i1 = pn * 128; u.i2 = 0; u.i3 = 0;
        return true;
    }
};
struct SchedDown {
    const bf16_t *HID, *WDT; int g, c, nmt;
    __device__ __forceinline__ bool next(int i, GU& u) const {
        int rm, pn; if (!tile_order(i * g + c, NEXP * nmt, 4, rm, pn)) return false;
        const int mt = rm % nmt, e = rm / nmt;
        u.gidx = nullptr; u.A = HID + (size_t)(e * EROWS + mt * 256) * 1024; u.lda = 1024; u.B = WDT + ((size_t)e * DM + pn * 256) * 1024; u.ldb = 1024; u.nt = 16; u.i0 = e * EROWS + mt * 256; u.i1 = pn * 256; u.i2 = 0; u.i3 = 0;
        return true;
    }
};

__device__ __forceinline__ void tr_tile_w(const float* src, size_t sp, int k0, int n0s, bf16_t* dst, size_t dp, int n0d, LAS float* t, int lane, int split = 0, int f8 = 0) {
    const int r4 = lane >> 4, c4 = lane & 15; f32x4 v[16];
#pragma unroll
    for (int i = 0; i < 16; ++i) v[i] = *(const f32x4*)(src + (size_t)(k0 + 4 * i + r4) * sp + n0s + 4 * c4);
#pragma unroll
    for (int i = 0; i < 16; ++i) {
#pragma unroll
        for (int j = 0; j < 4; ++j) t[(4 * c4 + j) * 65 + 4 * i + r4] = v[i][j]; }
    asm volatile("s_waitcnt lgkmcnt(0)" ::: "memory");
    const int n8 = lane >> 3, k8 = (lane & 7) * 8;
#pragma unroll
    for (int ps = 0; ps < 8; ++ps) { const int n = ps * 8 + n8; const LAS float* r = t + n * 65 + k8;
        if (f8) { u32x2 o; o.x = pk4_fp8(r[0] * W8S, r[1] * W8S, r[2] * W8S, r[3] * W8S); o.y = pk4_fp8(r[4] * W8S, r[5] * W8S, r[6] * W8S, r[7] * W8S);
            *(u32x2*)((unsigned char*)dst + (size_t)(n0d + (split == 2 ? ((n >> 3) * 16 + (n & 7)) : n)) * dp + k0 + k8) = o; }
        else { u32x4 o; o.x = pk2(r[0], r[1]); o.y = pk2(r[2], r[3]); o.z = pk2(r[4], r[5]); o.w = pk2(r[6], r[7]);
            *(u32x4*)(dst + (size_t)(n0d + n + ((split && n >= 32) ? 96 : 0)) * dp + k0 + k8) = o; } }
    asm volatile("s_waitcnt lgkmcnt(0)" ::: "memory");
}

template <int PART> __device__ __forceinline__ void ph_pre1(const Prm& p, LAS unsigned char* lds) {
    const int tid = tid_(), G = nblk_(), B = bid_();
    unsigned char* ws = p.ws;
    if constexpr (PART < 0 || PART == 0) {
        LAS float* sc = (LAS float*)lds; LAS float* red = sc + 17 * 1024;
        float* modv = (float*)(ws + O_MODV);
        bool loaded = false;
        for (int u = B; u < 96; u += G) {
            if (!loaded) { for (int i = tid; i < 17 * 1024; i += NT) { const int r = i >> 10, k = i & 1023; const float v = r < 16 ? p.c[r * 1024 + k] : p.c_ctx[k]; sc[i] = v / (1.0f + expf(-v)); } __syncthreads(); loaded = true; }
            const int l = u / 24, nb = u % 24, cl = tid & 255, col = nb * 256 + cl, kh = tid >> 8;
            float acc[17];
#pragma unroll
            for (int r = 0; r < 17; ++r) acc[r] = 0.f;
            const float* w = p.w_mod + (size_t)l * 1024 * 6144 + col;
            for (int k = kh * 512; k < kh * 512 + 512; ++k) { const float wv = w[(size_t)k * 6144];
#pragma unroll
                for (int r = 0; r < 17; ++r) acc[r] += sc[r * 1024 + k] * wv; }
            if (kh == 1) {
#pragma unroll
                for (int r = 0; r < 17; ++r) red[cl * 17 + r] = acc[r]; }
            __syncthreads();
            if (kh == 0) { const float bb = p.b_mod[l * 6144 + col];
#pragma unroll
                for (int r = 0; r < 17; ++r) modv[((size_t)l * 17 + r) * 6144 + col] = acc[r] + red[cl * 17 + r] + bb; }
            __syncthreads();
        }
        __syncthreads();
    }
    if constexpr (PART < 0 || PART == 1) {
        const int lane = tid & 63, wv = tid >> 6; LAS float* t = (LAS float*)lds + wv * (64 * 65);
        constexpr int PER_L = 192 + 768 + 192 + 256 + 256 + 3 * 8192;
        __syncthreads();
        unsigned* qc = (unsigned*)(ws + O_QCNT);
        for (;;) {
          int job0 = 0; if (lane == 0) job0 = (int)atomicAdd(qc, 4u); job0 = __builtin_amdgcn_readfirstlane(job0);
          if (job0 >= NLAYER * PER_L) break;
          for (int job = job0; job < job0 + 4; ++job) {
            const int l = job / PER_L; int j = job % PER_L;
            const float* win = p.w_in + (size_t)l * DM * INW;
            bf16_t* winm = (bf16_t*)(ws + O_WINM) + (size_t)l * PMW * DM; bf16_t* wins = (bf16_t*)(ws + O_WINS) + (size_t)l * SWR * DM;
            if (j < 192) { const int nt = j / 16, kt = j % 16; tr_tile_w(win, INW, kt * 64, nt * 64, winm, DM, nt * 64, t, lane, 0, 1); continue; } j -= 192;
            if (j < 768) { const int nt = j / 16, kt = j % 16; tr_tile_w(win, INW, kt * 64, OFF_GATE + nt * 64, (bf16_t*)(ws + O_WG8 + (size_t)l * 3072 * DM), DM, nt * 64, t, lane, 0, 1); continue; } j -= 768;
            if (j < 192) { const int nt = j / 16, kt = j % 16; tr_tile_w(win, INW, kt * 64, OFF_HY + nt * 64, wins, DM, nt * 64, t, lane); continue; } j -= 192;
            if (j < 256) { const int nt = j / 16, kt = j % 16; tr_tile_w(p.w_branch + (size_t)l * DM * DM, DM, kt * 64, nt * 64, (bf16_t*)(ws + O_WBT) + (size_t)l * DM * DM, DM, nt * 64, t, lane); continue; } j -= 256;
            if (j < 256) { const int nt = j / 16, kt = j % 16; tr_tile_w(p.w_out + (size_t)l * DM * DM, DM, kt * 64, nt * 64, (bf16_t*)(ws + O_WOT) + (size_t)l * DM * DM, DM, nt * 64, t, lane); continue; } j -= 256;
            if (j < 16384) { const int up = j / 8192; j %= 8192; const int e = j / 512, r = j % 512, nt = r / 16, kt = r % 16;
                const float* src = (up ? p.w_up : p.w_gate) + ((size_t)l * NEXP + e) * DM * FF;
                bf16_t* dst = (bf16_t*)(ws + O_WGU + ((size_t)l * NEXP + e) * 4096 * DM);
                tr_tile_w(src, FF, kt * 64, nt * 64, dst, DM, nt * 128 + up * 8, t, lane, 2, 1); continue; } j -= 16384;
            { const int e = j / 512, r = j % 512, nt = r / 32, kt = r % 32;
              tr_tile_w(p.w_down + ((size_t)l * NEXP + e) * FF * DM, DM, kt * 64, nt * 64, (bf16_t*)(ws + O_WDT + ((size_t)l * NEXP + e) * DM * FF), FF, nt * 64, t, lane, 0, 1); }
          }
        }
        __syncthreads();
    }
    if constexpr (PART < 0 || PART == 2) {
        LAS float* wt = (LAS float*)lds; LAS float* cs = wt + 64 * 65; LAS float* sn = cs + 64;
        for (int u = B; u < NLAYER * 4 * 16; u += G) {
            const int l = u >> 6, g = (u >> 4) & 3, kb = u & 15;
            __syncthreads();
            if (tid < 64) { float s, c; sincospif((float)tid / 32.0f, &s, &c); cs[tid] = c; sn[tid] = s; }
            const float* win = p.w_in + (size_t)l * DM * INW;
#pragma unroll
            for (int q = 0; q < 8; ++q) { const int e = tid + q * NT, i = e >> 6, j = e & 63; wt[i * 65 + j] = win[(size_t)(kb * 64 + i) * INW + OFF_FN + g * 64 + j]; }
            __syncthreads();
            const int k = tid & 63, jq = tid >> 6; bf16_t* wins = (bf16_t*)(ws + O_WINS) + (size_t)l * SWR * DM;
#pragma unroll 1
            for (int jj = 0; jj < 8; ++jj) { const int j = jq * 8 + jj; float P = 0.f, Q = 0.f;
#pragma unroll 4
                for (int c = 0; c < 64; ++c) { const float w = wt[k * 65 + c]; const int m = (c * j) & 63; P += w * cs[m]; Q += w * sn[m]; }
                wins[(size_t)(768 + g * 64 + j) * DM + kb * 64 + k] = (bf16_t)f2bf(P); wins[(size_t)(1024 + g * 64 + j) * DM + kb * 64 + k] = (bf16_t)f2bf(Q); }
        }
        __syncthreads();
    }
    if constexpr (PART < 0 || PART == 3) {
        LAS float* feats = (LAS float*)lds; LAS float* h1 = feats + 32 * 33; LAS float* h2 = h1 + 32 * 64; LAS float* tpos = h2 + 32 * 64;
        float* hraw = (float*)(ws + O_HRAW);
        for (int u = B; u < NLAYER * 72; u += G) {
            const int l = u / 72, pb = u % 72; const bool lat = pb < 64; const int n = lat ? LSEQ : LCTX, p0 = lat ? pb * 32 : (pb - 64) * 32;
            __syncthreads();
            for (int e = tid; e < 32 * 33; e += NT) { const int pp = e / 33, i = e % 33; const int pos = p0 + pp; float v;
                const float tt = (float)pos / (float)(n - 1);
                if (i == 0) { v = tt; tpos[pp] = tt; }
                else { const int bi = (i - 1) & 15; const double band = 1e-4 + (double)bi * ((15.0 - 1e-4) / 15.0); const float xpi = (float)((2.0 / (double)n) * (double)pos * band); float sn_, cs_; sincospif(xpi, &sn_, &cs_);
                       v = (i <= 16) ? cs_ : -sn_; }
                feats[e] = v; }
            __syncthreads();
            const float* w1 = p.hy_w1 + (size_t)l * 33 * 64; const float* w2 = p.hy_w2 + (size_t)l * 64 * 64; const float* w3 = p.hy_w3 + (size_t)l * 64 * 1024;
            { const int j = tid & 63; const float fq_ = p.hy_freq[l * 64 + j], bb = p.hy_b1[l * 64 + j];
#pragma unroll 1
              for (int k = 0; k < 4; ++k) { const int pp = (tid >> 6) + 8 * k; float s = bb;
#pragma unroll 3
                  for (int i = 0; i < 33; ++i) s += feats[pp * 33 + i] * w1[i * 64 + j]; h1[pp * 64 + j] = sinf(fq_ * s); } }
            __syncthreads();
            { const int j = tid & 63; const float fq_ = p.hy_freq[l * 64 + j], bb = p.hy_b2[l * 64 + j];
#pragma unroll 1
              for (int k = 0; k < 4; ++k) { const int pp = (tid >> 6) + 8 * k; float s = bb;
#pragma unroll 4
                  for (int i = 0; i < 64; ++i) s += h1[pp * 64 + i] * w2[i * 64 + j]; h2[pp * 64 + j] = sinf(fq_ * s); } }
            __syncthreads();
#pragma unroll 1
            for (int half = 0; half < 2; ++half) {
                const int col = tid + half * 512; float acc[32];
#pragma unroll
                for (int pp = 0; pp < 32; ++pp) acc[pp] = 0.f;
#pragma unroll 2
                for (int i = 0; i < 64; ++i) { const float w = w3[i * 1024 + col];
#pragma unroll
                    for (int pp = 0; pp < 32; ++pp) acc[pp] += h2[pp * 64 + i] * w; }
                const int ch = col & 255; const float delta = 3.0701134573253943f + (float)ch * ((15.350567286626972f - 3.0701134573253943f) / 255.0f);
#pragma unroll
                for (int pp = 0; pp < 32; ++pp) hraw[((size_t)l * TPB + (lat ? 0 : LSEQ) + p0 + pp) * 1024 + col] = acc[pp] * expf(-tpos[pp] * delta);
            }
        }
        __syncthreads();
    }
    if constexpr (PART < 0 || PART == 4) {
        bf16_t* dftm = (bf16_t*)(ws + O_DFTM); bf16_t* dftc = (bf16_t*)(ws + O_DFTC); float* rope = (float*)(ws + O_ROPE);
        const size_t gt = (size_t)B * NT + tid, gs = (size_t)G * NT;
        for (size_t e = gt; e < (size_t)LSEQ * 256; e += gs) { const int t = (int)(e >> 8), j0 = (int)(e & 255) * 8; unsigned w[4];
#pragma unroll
            for (int q = 0; q < 4; ++q) { float v[2];
#pragma unroll
                for (int z = 0; z < 2; ++z) { const int j = j0 + 2 * q + z; const bool cp = j <= 1024; const int s = cp ? j : j - 1024, m = (t * s) & 2047; float sn_, cs_; sincospif((float)m / 1024.0f, &sn_, &cs_); v[z] = (cp ? cs_ : -sn_) * (1.0f / 362.03867196751236f); }
                w[q] = pk2(v[0], v[1]); }
            *(u32x4*)(dftm + (size_t)t * 2048 + j0) = (u32x4){w[0], w[1], w[2], w[3]}; }
        for (size_t e = gt; e < (size_t)LCTX * 32; e += gs) { const int t = (int)(e >> 5), j0 = (int)(e & 31) * 8; unsigned w[4];
#pragma unroll
            for (int q = 0; q < 4; ++q) { float v[2];
#pragma unroll
                for (int z = 0; z < 2; ++z) { const int j = j0 + 2 * q + z; const bool cp = j <= 128; const int s = cp ? j : j - 128, m = (t * s) & 255; float sn_, cs_; sincospif((float)m / 128.0f, &sn_, &cs_); v[z] = (cp ? cs_ : -sn_) * (1.0f / 128.0f); }
                w[q] = pk2(v[0], v[1]); }
            *(u32x4*)(dftc + (size_t)t * 256 + j0) = (u32x4){w[0], w[1], w[2], w[3]}; }
        for (size_t e = gt; e < (size_t)LSEQ * 32; e += gs) { const int t = (int)(e >> 5), j = (int)(e & 31); const int pos = j < 16 ? (t >> 6) : (t & 63); const int ii = j & 15;
            const float inv = powf(10000.0f, -(float)ii / 16.0f); const float ang = (float)pos * inv; rope[e * 2] = cosf(ang); rope[e * 2 + 1] = sinf(ang); }
    }
}

__device__ __forceinline__ void ph_pre2(const Prm& p, LAS unsigned char* lds) {
    const int tid = tid_(), G = nblk_(), B = bid_();
    LAS float* red = (LAS float*)lds; LAS float* inv = red + 512; LAS float* tile = inv + 64;
    const float* hraw = (const float*)(p.ws + O_HRAW);
    for (int u = B; u < NLAYER * 2 * 8 * 4; u += G) {
        const int qt = u & 3, l = u >> 6, len = (u >> 5) & 1, ob = (u >> 2) & 7; const int n = len ? LCTX : LSEQ; const int c = tid & 63, ps = tid >> 6, oc = ob * 64 + c;
        const float* hr = hraw + ((size_t)l * TPB + (len ? LSEQ : 0)) * 1024;
        float s = 0.f;
        for (int pp0 = ps; pp0 < n; pp0 += 64) { float a[8], bq[8];
#pragma unroll
            for (int z = 0; z < 8; ++z) { const int pp = pp0 + 8 * z; a[z] = hr[(size_t)pp * 1024 + oc]; bq[z] = hr[(size_t)pp * 1024 + 512 + oc]; }
#pragma unroll
            for (int z = 0; z < 8; ++z) { s += fabsf(a[z]); if (pp0 + 8 * z >= 1) s += fabsf(bq[z]); } }
        __syncthreads();
        red[tid] = s; __syncthreads();
        if (tid < 64) { float a = 0.f; for (int q = 0; q < 8; ++q) a += red[q * 64 + tid]; inv[tid] = 1.0f / a; }
        __syncthreads();
        bf16_t* gbase = len ? (bf16_t*)(p.ws + O_GFC) + ((size_t)l * 512 + ob * 64) * 512 : (bf16_t*)(p.ws + O_GFL) + ((size_t)l * 512 + ob * 64) * 4096;
        const int rowlen = 2 * n;
        for (int pc = qt * (n >> 2); pc < (qt + 1) * (n >> 2); pc += 64) {
#pragma unroll
            for (int q = 0; q < 16; ++q) { const int e = tid + q * NT, d = e >> 12, pp = (e >> 6) & 63, cc = e & 63; tile[(d * 64 + pp) * 65 + cc] = hr[(size_t)(pc + pp) * 1024 + d * 512 + ob * 64 + cc] * inv[cc]; }
            __syncthreads();
            { const int cc = tid >> 3, q0 = (tid & 7) * 8; bf16_t* grow = gbase + (size_t)cc * rowlen;
              u32x4 o; o.x = pk2(tile[(q0 + 7) * 65 + cc], tile[(q0 + 6) * 65 + cc]); o.y = pk2(tile[(q0 + 5) * 65 + cc], tile[(q0 + 4) * 65 + cc]);
              o.z = pk2(tile[(q0 + 3) * 65 + cc], tile[(q0 + 2) * 65 + cc]); o.w = pk2(tile[(q0 + 1) * 65 + cc], tile[(q0 + 0) * 65 + cc]);
              *(u32x4*)(grow + (n - 8 - pc - q0)) = o;
#pragma unroll
              for (int z = 0; z < 8; ++z) { const int pos = pc + q0 + z; if (pos >= 1) grow[n - 1 + pos] = (bf16_t)f2bf(tile[(64 + q0 + z) * 65 + cc]); }
              if (pc == 0 && q0 == 0) grow[2 * n - 1] = 0; }
            __syncthreads();
        }
    }
}

typedef float f32x2v __attribute__((ext_vector_type(2)));
__device__ __forceinline__ void ph_norm1(const Prm& p, int l, LAS unsigned char* lds) {
    const int tid = tid_(), lane = tid & 63, wv = tid >> 6; unsigned char* ws = p.ws;
    bf16_t* xs = (bf16_t*)(ws + O_XS); bf16_t* H = (bf16_t*)(ws + O_H); const float* modv = (const float*)(ws + O_MODV);
    const unsigned char* Y = (const unsigned char*)(ws + O_Y); const float* aff = (const float*)(ws + O_AFF); const int* sel = (const int*)(ws + O_SEL);
    LAS float* mv = (LAS float*)lds;
    const bool fin = (l == NLAYER); const int NR = fin ? NBATCH * LSEQ : NTOK;
    const int rpb = (NR + nblk_() - 1) / nblk_(); const int i0 = bid_() * rpb; const int i1 = (i0 + rpb < NR) ? i0 + rpb : NR;
    u32x2 nv[4]; int nsl = -1; float naf = 0.f; const bf16_t* Y16 = (const bf16_t*)(ws + O_MIX);
#define N1_LOADROW(rr) do { _Pragma("unroll") for (int q = 0; q < 4; ++q) nv[q] = *(const u32x2*)(xs + (size_t)(rr) * DM + q * 256 + lane * 4); \
        nsl = sel[(size_t)(rr) * 16 + (lane & 15)]; naf = aff[(size_t)(rr) * 16 + (lane & 15)]; } while (0)
#pragma unroll 1
    for (int s0 = i0; s0 < i1; ) {
        const int b = fin ? s0 / LSEQ : s0 / TPB, t0 = fin ? s0 % LSEQ : s0 % TPB; const bool isctx = t0 >= LSEQ; const int mrow = isctx ? 16 : b;
        const int segend = fin ? (b + 1) * LSEQ : b * TPB + (isctx ? TPB : LSEQ); const int s1 = segend < i1 ? segend : i1;
        const int roff = fin ? b * (TPB - LSEQ) : 0;
        __syncthreads();
#pragma unroll
        for (int k = 0; k < 2; ++k) { const int i = tid + k * NT, which = i >> 8, c = (i & 255) * 4; f32x4 val = (f32x4){0.f, 0.f, 0.f, 0.f};
            if (which < 2) { if (l > 0) val = *(const f32x4*)(modv + ((size_t)(l - 1) * 17 + mrow) * 6144 + (which == 0 ? 2 : 5) * 1024 + c); }
            else if (fin) { if (which == 2) val = *(const f32x4*)(p.final_g + c); }
            else { const float* ml = modv + ((size_t)l * 17 + mrow) * 6144;
                if (which == 2) val = *(const f32x4*)(p.norm1_g + l * DM + c) * (*(const f32x4*)(ml + 1024 + c) + 1.0f); else val = *(const f32x4*)(ml + c); }
            *(LAS f32x4*)(mv + which * 1024 + c) = val; }
        __syncthreads();
        int i = s0 + wv;
        if (l > 0 && i < s1) N1_LOADROW(i + roff);
#pragma unroll 1
        for (; i < s1; i += 8) {
            const int r = i + roff; const int t = fin ? i % LSEQ : i % TPB;
            f32x4 v[4];
            if (l == 0) { const float* src = isctx ? p.ctx + ((size_t)b * LCTX + (t - LSEQ)) * DM : p.x + ((size_t)b * LSEQ + t) * DM;
#pragma unroll
                for (int q = 0; q < 4; ++q) v[q] = *(const f32x4*)(src + q * 256 + lane * 4); }
            else {
                u32x2 ny[4];
#pragma unroll
                for (int q = 0; q < 4; ++q) { v[q] = (f32x4){bflo(nv[q].x), bfhi(nv[q].x), bflo(nv[q].y), bfhi(nv[q].y)}; ny[q] = *(const u32x2*)(Y16 + (size_t)r * DM + q * 256 + lane * 4); }
                f32x4 a[4];
#pragma unroll
                for (int q = 0; q < 4; ++q) a[q] = (f32x4){0.f, 0.f, 0.f, 0.f};
                unsigned em = (unsigned)__ballot(nsl >= 0) & 0xffffu;
#pragma unroll 1
                do {
                    unsigned y[8][4]; float w[8];
#pragma unroll
                    for (int k = 0; k < 8; ++k) {
                        if (em != 0u) { const int e = __builtin_ctz(em); em &= em - 1u;
                            const int se = __builtin_amdgcn_readlane(nsl, e); w[k] = __builtin_bit_cast(float, __builtin_amdgcn_readlane(__builtin_bit_cast(int, naf), e)) * Y8I;
                            const unsigned char* yr = Y + ((size_t)e * EROWS + se) * DM; const unsigned lo4 = (unsigned)lane * 4u;
#pragma unroll
                            for (int q = 0; q < 4; ++q) y[k][q] = *(const unsigned*)(yr + lo4 + q * 256); }
                        else { w[k] = 0.f;
#pragma unroll
                            for (int q = 0; q < 4; ++q) y[k][q] = 0u; } }
#pragma unroll
                    for (int k = 0; k < 8; ++k) {
#pragma unroll
                        for (int q = 0; q < 4; ++q) { const f32x2v lo2 = __builtin_amdgcn_cvt_pk_f32_fp8((int)y[k][q], false), hi2 = __builtin_amdgcn_cvt_pk_f32_fp8((int)y[k][q], true);
                            a[q][0] += w[k] * lo2[0]; a[q][1] += w[k] * lo2[1]; a[q][2] += w[k] * hi2[0]; a[q][3] += w[k] * hi2[1]; }
                        __builtin_amdgcn_sched_barrier(0); }
                    asm volatile("" : "+v"(a[0]), "+v"(a[1]), "+v"(a[2]), "+v"(a[3]) :: "memory");
                } while (em != 0u);
                if (i + 8 < s1) N1_LOADROW(r + 8);
#pragma unroll
                for (int q = 0; q < 4; ++q) { const f32x4 g1 = *(const LAS f32x4*)(mv + q * 256 + lane * 4), g = *(const LAS f32x4*)(mv + 1024 + q * 256 + lane * 4);
                    v[q] += g * a[q]; v[q][0] += g1[0] * bflo(ny[q].x); v[q][1] += g1[1] * bfhi(ny[q].x); v[q][2] += g1[2] * bflo(ny[q].y); v[q][3] += g1[3] * bfhi(ny[q].y); }
            }
            float ss = 0.f;
#pragma unroll
            for (int q = 0; q < 4; ++q) ss += v[q][0] * v[q][0] + v[q][1] * v[q][1] + v[q][2] * v[q][2] + v[q][3] * v[q][3];
            ss = wave_sum(ss); const float rstd = rsqrtf(ss * (1.0f / DM) + EPS);
            if (fin) {
                float* o = p.out + (size_t)i * DM;
#pragma unroll
                for (int q = 0; q < 4; ++q) { const f32x4 g = *(const LAS f32x4*)(mv + 2048 + q * 256 + lane * 4); *(f32x4*)(o + q * 256 + lane * 4) = v[q] * rstd * g; }
            } else {
#pragma unroll
                for (int q = 0; q < 4; ++q) { const int c = q * 256 + lane * 4; { u32x2 xo; xo.x = pk2(v[q][0], v[q][1]); xo.y = pk2(v[q][2], v[q][3]); *(u32x2*)(xs + (size_t)r * DM + c) = xo; }
                    const f32x4 ga = *(const LAS f32x4*)(mv + 2048 + c), sh = *(const LAS f32x4*)(mv + 3072 + c);
                    const f32x4 h = (v[q] * rstd) * ga + sh; u32x2 o; o.x = pk2(h[0], h[1]); o.y = pk2(h[2], h[3]); *(u32x2*)(H + (size_t)r * DM + c) = o;
                    *(unsigned*)(ws + O_H8G + (size_t)r * DM + c) = pk4_fp8(h[0], h[1], h[2], h[3]); }
            }
        }
        s0 = s1;
    }
#undef N1_LOADROW
}

__device__ __forceinline__ void ph_qkprep(const Prm& p, int l) {
    const int tid = tid_(), lane = tid & 63, wv = tid >> 6; unsigned char* ws = p.ws;
    const bf16_t* PM = (const bf16_t*)(ws + O_PM); bf16_t* QP = (bf16_t*)(ws + O_QP); bf16_t* KP = (bf16_t*)(ws + O_KP); const float* rope = (const float*)(ws + O_ROPE);
    const float C2 = 0.125f * 1.4426950408889634f;
    for (int r = bid_() * 8 + wv; r < NTOK; r += nblk_() * 8) {
        const int t = r % TPB; const bool isctx = t >= LSEQ;
#pragma unroll
        for (int part = 0; part < 2; ++part) {
            if (part == 1 && lane >= 16) break;
            const int c0 = part == 0 ? lane * 8 : 512 + lane * 8;
            const u32x4 raw = *(const u32x4*)(PM + (size_t)r * PMW + c0);
            float v[8]; v[0] = bflo(raw.x); v[1] = bfhi(raw.x); v[2] = bflo(raw.y); v[3] = bfhi(raw.y); v[4] = bflo(raw.z); v[5] = bfhi(raw.z); v[6] = bflo(raw.w); v[7] = bfhi(raw.w);
            float ss = 0.f;
#pragma unroll
            for (int j = 0; j < 8; ++j) ss += v[j] * v[j];
            ss += __shfl_xor(ss, 1); ss += __shfl_xor(ss, 2); ss += __shfl_xor(ss, 4);
            const float rstd = rsqrtf(ss * (1.0f / 64.0f) + EPS);
            const int d0 = (lane & 7) * 8; const float* gn = (part == 0 ? p.q_gain : p.k_gain) + l * 64 + d0;
#pragma unroll
            for (int j = 0; j < 8; ++j) v[j] = v[j] * rstd * gn[j];
            if (!isctx) {
#pragma unroll
                for (int j = 0; j < 4; ++j) { const int pr = (d0 >> 1) + j; const float cs = rope[((size_t)t * 32 + pr) * 2], sn = rope[((size_t)t * 32 + pr) * 2 + 1];
                    const float a = v[2 * j], bq = v[2 * j + 1]; v[2 * j] = a * cs - bq * sn; v[2 * j + 1] = a * sn + bq * cs; }
            }
            const float sc = part == 0 ? C2 : 1.0f;
            u32x4 o; o.x = pk2(v[0] * sc, v[1] * sc); o.y = pk2(v[2] * sc, v[3] * sc); o.z = pk2(v[4] * sc, v[5] * sc); o.w = pk2(v[6] * sc, v[7] * sc);
            if (part == 0) *(u32x4*)(QP + (size_t)r * 512 + lane * 8) = o; else *(u32x4*)(KP + (size_t)r * 128 + lane * 8) = o;
        }
    }
}

__device__ __forceinline__ void ph_attn_naive(const Prm& p, int l, LAS unsigned char* lds) {
    const int tid = tid_(); unsigned char* ws = p.ws;
    const bf16_t* PM = (const bf16_t*)(ws + O_PM); const bf16_t* QP = (const bf16_t*)(ws + O_QP); const bf16_t* KP = (const bf16_t*)(ws + O_KP); bf16_t* MIX = (bf16_t*)(ws + O_MIX);
    LAS float* Ks = (LAS float*)lds; LAS float* Vs = Ks + 32 * 64;
    for (int u = bid_(); u < NBATCH * 2 * 18; u += nblk_()) {
        const int qc = u % 18, g = (u / 18) & 1, b = u / 36; const bool isctx = qc >= 16;
        if (isctx && l == NLAYER - 1) continue;
        const int qrow = b * TPB + qc * 128 + (tid & 127), hq = g * 4 + (tid >> 7);
        const int k0 = isctx ? LSEQ : 0, nk = isctx ? LCTX : TPB;
        float q[64], o[64];
#pragma unroll
        for (int j = 0; j < 8; ++j) { const u32x4 raw = *(const u32x4*)(QP + (size_t)qrow * 512 + hq * 64 + j * 8);
            q[8 * j] = bflo(raw.x); q[8 * j + 1] = bfhi(raw.x); q[8 * j + 2] = bflo(raw.y); q[8 * j + 3] = bfhi(raw.y); q[8 * j + 4] = bflo(raw.z); q[8 * j + 5] = bfhi(raw.z); q[8 * j + 6] = bflo(raw.w); q[8 * j + 7] = bfhi(raw.w); }
#pragma unroll
        for (int j = 0; j < 64; ++j) o[j] = 0.f;
        float mx = -1e30f, den = 0.f;
        for (int kb = 0; kb < nk; kb += 32) {
            __syncthreads();
            { const int kk = tid >> 4, d4 = (tid & 15) * 4; const size_t krow = (size_t)b * TPB + k0 + kb + kk;
              const u32x2 kr = *(const u32x2*)(KP + krow * 128 + g * 64 + d4); const u32x2 vr = *(const u32x2*)(PM + krow * PMW + 640 + g * 64 + d4);
              *(LAS f32x4*)(Ks + kk * 64 + d4) = (f32x4){bflo(kr.x), bfhi(kr.x), bflo(kr.y), bfhi(kr.y)};
              *(LAS f32x4*)(Vs + kk * 64 + d4) = (f32x4){bflo(vr.x), bfhi(vr.x), bflo(vr.y), bfhi(vr.y)}; }
            __syncthreads();
#pragma unroll 1
            for (int kk = 0; kk < 32; ++kk) {
                float a0 = 0.f, a1 = 0.f;
#pragma unroll
                for (int d4 = 0; d4 < 64; d4 += 8) { const f32x4 kv = *(const LAS f32x4*)(Ks + kk * 64 + d4); const f32x4 kw = *(const LAS f32x4*)(Ks + kk * 64 + d4 + 4);
                    a0 += q[d4] * kv[0] + q[d4 + 1] * kv[1] + q[d4 + 2] * kv[2] + q[d4 + 3] * kv[3]; a1 += q[d4 + 4] * kw[0] + q[d4 + 5] * kw[1] + q[d4 + 6] * kw[2] + q[d4 + 7] * kw[3]; }
                const float a = a0 + a1;
                if (a > mx) { const float sc = exp2f(mx - a); mx = a; den *= sc;
#pragma unroll
                    for (int j = 0; j < 64; ++j) o[j] *= sc; }
                const float pw = exp2f(a - mx); den += pw;
#pragma unroll
                for (int d4 = 0; d4 < 64; d4 += 4) { const f32x4 vv = *(const LAS f32x4*)(Vs + kk * 64 + d4); o[d4] += pw * vv[0]; o[d4 + 1] += pw * vv[1]; o[d4 + 2] += pw * vv[2]; o[d4 + 3] += pw * vv[3]; }
            }
        }
        const float inv = 1.0f / den;
#pragma unroll
        for (int j = 0; j < 8; ++j) { u32x4 w; w.x = pk2(o[8 * j] * inv, o[8 * j + 1] * inv); w.y = pk2(o[8 * j + 2] * inv, o[8 * j + 3] * inv); w.z = pk2(o[8 * j + 4] * inv, o[8 * j + 5] * inv); w.w = pk2(o[8 * j + 6] * inv, o[8 * j + 7] * inv);
            *(u32x4*)(MIX + (size_t)qrow * DM + hq * 64 + j * 8) = w; }
    }
}

namespace attn_body {
using bf16=__hip_bfloat16;
using bf16x8=__attribute__((ext_vector_type(8)))short;
using s16x4=__attribute__((ext_vector_type(4)))short;
using f32x16=__attribute__((ext_vector_type(16)))float;
using u32x4=__attribute__((ext_vector_type(4)))unsigned;
constexpr int D=64;
constexpr int NW=8,QBLK=32,QB=QBLK*NW,KVBLK=64;
__device__ __forceinline__ int crow(int r,int hi){return (r&3)+8*(r>>2)+4*hi;}
#define SBAR() __builtin_amdgcn_sched_barrier(0)
constexpr int NSLOT=3, SLOTB=8192;
constexpr int LDS_K=0, LDS_V=NSLOT*SLOTB, LDS_WS=2*NSLOT*SLOTB, LDS_OST=LDS_WS+NW*64*4, LDS_BYTES=LDS_OST+NW*4096;
constexpr float C2=0.125f*1.4426950408889634f;
__device__ __forceinline__ void glds16(const void*gsrc,unsigned lds_dst){unsigned keep;
  asm volatile("s_mov_b32 %0, m0\n\ts_mov_b32 m0, %2\n\ts_nop 0\n\tglobal_load_lds_dwordx4 %1, off\n\ts_mov_b32 m0, %0":"=&s"(keep):"v"(gsrc),"s"(lds_dst):"memory");}
__device__ __forceinline__ float max3f(float a,float b,float c){float r;asm("v_max3_f32 %0, %1, %2, %3":"=v"(r):"v"(a),"v"(b),"v"(c));return r;}
__device__ __forceinline__ float max2f(float a,float b){float r;asm("v_max_f32_e32 %0, %1, %2":"=v"(r):"v"(a),"v"(b));return r;}
__device__ __forceinline__ float fadd_s(float a,float b){float r;asm("v_add_f32_e32 %0, %1, %2":"=v"(r):"v"(a),"v"(b));return r;}
__device__ __forceinline__ float fsub_s(float a,float b){float r;asm("v_sub_f32_e32 %0, %1, %2":"=v"(r):"v"(a),"v"(b));return r;}
typedef float f32x2_t __attribute__((ext_vector_type(2))); typedef __bf16 bf16x2_t __attribute__((ext_vector_type(2)));
__device__ __forceinline__ unsigned cvtpk_s(float lo,float hi){f32x2_t v={lo,hi};bf16x2_t b=__builtin_convertvector(v,bf16x2_t);return __builtin_bit_cast(unsigned,b);}
#define WAIT_BAR(N) asm volatile("s_waitcnt vmcnt(" #N ") lgkmcnt(0)\n\ts_barrier":::"memory")

__device__ __forceinline__ void qkt(f32x16&p0,f32x16&p1,const char*Kslot,const bf16x8*qr,const f32x16&negm,int r32,int hi){
  const char*kb=Kslot+hi*1024+r32*16;
  #pragma unroll
  for(int d0=0;d0<4;++d0){
    const bf16x8 b0=*reinterpret_cast<const bf16x8*>(kb+d0*2048);
    const bf16x8 b1=*reinterpret_cast<const bf16x8*>(kb+d0*2048+512);
    if(d0==0){p0=__builtin_amdgcn_mfma_f32_32x32x16_bf16(b0,qr[0],negm,0,0,0);p1=__builtin_amdgcn_mfma_f32_32x32x16_bf16(b1,qr[0],negm,0,0,0);}
    else{p0=__builtin_amdgcn_mfma_f32_32x32x16_bf16(b0,qr[d0],p0,0,0,0);p1=__builtin_amdgcn_mfma_f32_32x32x16_bf16(b1,qr[d0],p1,0,0,0);}}
}
typedef __attribute__((address_space(3))) const char* lds_cptr;
typedef short v4i16_t __attribute__((ext_vector_type(4)));
__device__ __forceinline__ void kload8(bf16x8*kf,lds_cptr kp){
  kf[0]=*(const __attribute__((address_space(3))) bf16x8*)(kp);      kf[1]=*(const __attribute__((address_space(3))) bf16x8*)(kp+512);
  kf[2]=*(const __attribute__((address_space(3))) bf16x8*)(kp+2048); kf[3]=*(const __attribute__((address_space(3))) bf16x8*)(kp+2560);
  kf[4]=*(const __attribute__((address_space(3))) bf16x8*)(kp+4096); kf[5]=*(const __attribute__((address_space(3))) bf16x8*)(kp+4608);
  kf[6]=*(const __attribute__((address_space(3))) bf16x8*)(kp+6144); kf[7]=*(const __attribute__((address_space(3))) bf16x8*)(kp+6656);
}
__device__ __forceinline__ void kload2(bf16x8*kf,lds_cptr kp,int j){ kf[2*j]=*(const __attribute__((address_space(3))) bf16x8*)(kp+j*2048); kf[2*j+1]=*(const __attribute__((address_space(3))) bf16x8*)(kp+j*2048+512); }
__device__ __forceinline__ s16x4 vtr(lds_cptr p){ return __builtin_bit_cast(s16x4,__builtin_amdgcn_ds_read_tr16_b64_v4i16((__attribute__((address_space(3))) v4i16_t*)p)); }
__device__ __forceinline__ float rowmax(const f32x16&p0,const f32x16&p1){
  float a=max3f(p0[0],p0[1],p1[0]),b=max3f(p0[2],p0[3],p1[1]);a=max3f(a,p1[2],p1[3]);
  #pragma unroll
  for(int r=4;r<16;r+=4){a=max3f(a,p0[r],p0[r+1]);b=max3f(b,p0[r+2],p0[r+3]);a=max3f(a,p1[r],p1[r+1]);b=max3f(b,p1[r+2],p1[r+3]);}
  const float m=max2f(a,b);
  auto rr=__builtin_amdgcn_permlane32_swap(__float_as_uint(m),__float_as_uint(m),false,false);
  return max2f(__uint_as_float(rr[0]),__uint_as_float(rr[1]));
}
__device__ __forceinline__ void pv(f32x16*o,int vb,bf16x8 pa0,bf16x8 pa1,bf16x8 pa2,bf16x8 pa3){
  #pragma unroll
  for(int d0=0;d0<2;++d0){s16x4 lo[4],hi[4];
    #pragma unroll
    for(int ks=0;ks<4;++ks){
      asm volatile("ds_read_b64_tr_b16 %0,%1 offset:%c2":"=&v"(lo[ks]):"v"(vb),"i"(d0*4096+ks*1024):"memory");
      asm volatile("ds_read_b64_tr_b16 %0,%1 offset:%c2":"=&v"(hi[ks]):"v"(vb),"i"(d0*4096+ks*1024+512):"memory");}
    asm volatile("s_waitcnt lgkmcnt(0)":::"memory");SBAR();
    #define PK(k) (bf16x8){lo[k][0],lo[k][1],lo[k][2],lo[k][3],hi[k][0],hi[k][1],hi[k][2],hi[k][3]}
    o[d0]=__builtin_amdgcn_mfma_f32_32x32x16_bf16(pa0,PK(0),o[d0],0,0,0);
    o[d0]=__builtin_amdgcn_mfma_f32_32x32x16_bf16(pa1,PK(1),o[d0],0,0,0);
    o[d0]=__builtin_amdgcn_mfma_f32_32x32x16_bf16(pa2,PK(2),o[d0],0,0,0);
    o[d0]=__builtin_amdgcn_mfma_f32_32x32x16_bf16(pa3,PK(3),o[d0],0,0,0);
    #undef PK
  }
}

#ifndef ATTN_STORE16
#define ATTN_STORE16(p,v) (*(u32x4*)(p)=(v))
#endif
template<int THRL,int QPI,int KPI,int VPI,int OPI> __device__ __forceinline__ void attn_unit(const bf16*Qu,const bf16*__restrict__ Kh,const bf16*__restrict__ Vh,bf16*Ou,const int NT,char*shm,const float negc=0.f){
  const int tid=tid_(),lane=tid&63,r32=lane&31,hi=lane>>5; const int wid=__builtin_amdgcn_readfirstlane(tid>>6);
  const bf16*Qw=Qu+(long)(wid*QBLK)*QPI;
  const unsigned lds0=(unsigned)(uintptr_t)shm;
  float*wsf=(float*)(shm+LDS_WS)+wid*64;
  const bf16*ksrc=Kh+(long)lane*KPI+wid*8;
  const bf16*vsrc=Vh+(long)(16*(wid&3)+(lane>>2))*VPI+(wid>>2)*32+(lane&3)*8;
  const unsigned kdst=lds0+LDS_K+wid*1024, vdst=lds0+LDS_V+wid*1024;
  #define DMA_K(t,slot) glds16(ksrc+(long)(t)*KVBLK*KPI,(unsigned)__builtin_amdgcn_readfirstlane(kdst+(slot)))
  #define DMA_V(t,slot) glds16(vsrc+(long)(t)*KVBLK*VPI,(unsigned)__builtin_amdgcn_readfirstlane(vdst+(slot)))
  const int vb0=(int)(lds0+LDS_V)+((lane>>4)&1)*32+(lane&3)*8+(4*hi+((lane&15)>>2))*64;
  const char*Kbase=shm+LDS_K; bf16x8 kf[8];
  const lds_cptr shm3=(lds_cptr)shm; const lds_cptr kp0=shm3+LDS_K+hi*1024+r32*16; const lds_cptr vp0=shm3+LDS_V+((lane>>4)&1)*32+(lane&3)*8+(4*hi+((lane&15)>>2))*64;
  if (wid >= 4) __builtin_amdgcn_s_setprio(1);
  DMA_K(0,0);DMA_V(0,0);DMA_K(1,SLOTB);
  bf16x8 qr[4];
  #pragma unroll
  for(int d0=0;d0<4;++d0)qr[d0]=*reinterpret_cast<const bf16x8*>(&Qw[(long)r32*QPI+d0*16+hi*8]);
  float mhat=0.f,l_reg=0.f;f32x16 o[2];o[0]=f32x16{};o[1]=f32x16{};f32x16 negm=f32x16{}; if constexpr(THRL>=1000){ _Pragma("unroll") for(int r=0;r<16;++r)negm[r]=negc; } asm volatile("":"+v"(negm));
  #define CMASK(P0,P1,t) do{}while(0)
  bool resc=false;
  #define START(P0,P1) do{ resc=false; if constexpr(THRL<1000) \
    { const float rm=rowmax(P0,P1); const float dl=rm; mhat=fadd_s(mhat,dl); \
      _Pragma("unroll") for(int r=0;r<16;++r){P0[r]=fsub_s(P0[r],dl);P1[r]=fsub_s(P1[r],dl);} \
      _Pragma("unroll") for(int r=0;r<16;++r)negm[r]=-mhat; asm volatile("":"+v"(negm)); } \
    _Pragma("unroll") for(int r=0;r<16;++r)P0[r]=__builtin_amdgcn_exp2f(P0[r]); }while(0)
  #define RESC() do{ if(resc){ asm volatile("s_waitcnt lgkmcnt(0)":::"memory"); \
      _Pragma("unroll") for(int d_=0;d_<2;++d_) _Pragma("unroll") for(int r=0;r<16;++r)o[d_][r]*=wsf[crow(r,hi)]; } }while(0)
  f32x16 pA0,pA1,pB0,pB1;
  int sl_prev=0,sl_cur=0,sl_next=SLOTB;
  #define ROT() do{sl_prev=sl_cur;sl_cur=sl_next;sl_next=(sl_next==(NSLOT-1)*SLOTB)?0:sl_next+SLOTB;}while(0)
  DMA_K(2,2*SLOTB);
  WAIT_BAR(3);
  qkt(pA0,pA1,Kbase,qr,negm,r32,hi);asm volatile("s_nop 15\n\ts_nop 7":"+v"(pA0),"+v"(pA1));CMASK(pA0,pA1,0);
  START(pA0,pA1);
  _Pragma("unroll") for(int r=0;r<16;++r)pA1[r]=__builtin_amdgcn_exp2f(pA1[r]);
  WAIT_BAR(0);
  DMA_K(3,0);DMA_V(1,SLOTB);
  ROT();
  kload8(kf,kp0+sl_cur);
  WAIT_BAR(2);
  s16x4 vlo[8],vhi[8]; u32x4 pw0,pw1,pw2,pw3;
  #define PKW(P,B) cvtpk_s(P[B],P[B+1])
  #define PAF(k) __builtin_bit_cast(bf16x8,pw##k)
  #define VFR(i) (bf16x8){vlo[i][0],vlo[i][1],vlo[i][2],vlo[i][3],vhi[i][0],vhi[i][1],vhi[i][2],vhi[i][3]}
  #define PIN(x) asm volatile("":"+v"(x))
  #define MX3(a,b,c) __builtin_fmaxf(__builtin_fmaxf((a),(b)),(c))
  #define GAPA(MF,A0,A1,A2,A3,W0,W1,PW) do{ MF; sacc+=A0; sacc+=A1; sacc+=A2; sacc+=A3; PIN(sacc); W0; W1; PIN(PW); SBAR(); }while(0)
  #define EX(v) __builtin_amdgcn_exp2f(v)
  #define GAPB(MF,X,B) do{ MF; X[B]=EX(X[B]); X[B+1]=EX(X[B+1]); X[B+2]=EX(X[B+2]); X[B+3]=EX(X[B+3]); PIN(X); SBAR(); }while(0)
  #define VRD(i) do{ vlo[i]=vtr(vp_+(((i)>>2)*4096+((i)&3)*1024)); vhi[i]=vtr(vp_+(((i)>>2)*4096+((i)&3)*1024+512)); }while(0)
  #define KRD(G,j) do{ if(G){ kload2(kf,kp0+sl_next,j); SBAR(); } }while(0)
  #define STEP(C0,C1,P0,P1,t,GK,GV,GL) do{ SBAR(); \
    const lds_cptr vp_=vp0+sl_prev; \
    VRD(0); SBAR(); float sacc=(P0[0]+P0[1]); \
    GAPA(C0=__builtin_amdgcn_mfma_f32_32x32x16_bf16(kf[0],qr[0],negm,0,0,0), P0[2],P0[3],P0[4],P0[5],     pw0[0]=PKW(P0,0), pw0[1]=PKW(P0,2), pw0); \
    VRD(4); SBAR(); GAPA(C1=__builtin_amdgcn_mfma_f32_32x32x16_bf16(kf[1],qr[0],negm,0,0,0), P0[6],P0[7],P0[8],P0[9],     pw0[2]=PKW(P0,4), pw0[3]=PKW(P0,6), pw0); \
    VRD(1); SBAR(); GAPA(C0=__builtin_amdgcn_mfma_f32_32x32x16_bf16(kf[2],qr[1],C0,0,0,0),   P0[10],P0[11],P0[12],P0[13], pw1[0]=PKW(P0,8), pw1[1]=PKW(P0,10), pw1); \
    VRD(5); SBAR(); GAPA(C1=__builtin_amdgcn_mfma_f32_32x32x16_bf16(kf[3],qr[1],C1,0,0,0),   P0[14],P0[15],P1[0],P1[1],   pw1[2]=PKW(P0,12),pw1[3]=PKW(P0,14), pw1); \
    VRD(2); SBAR(); GAPA(C0=__builtin_amdgcn_mfma_f32_32x32x16_bf16(kf[4],qr[2],C0,0,0,0),   P1[2],P1[3],P1[4],P1[5],     pw2[0]=PKW(P1,0), pw2[1]=PKW(P1,2), pw2); \
    VRD(6); SBAR(); GAPA(C1=__builtin_amdgcn_mfma_f32_32x32x16_bf16(kf[5],qr[2],C1,0,0,0),   P1[6],P1[7],P1[8],P1[9],     pw2[2]=PKW(P1,4), pw2[3]=PKW(P1,6), pw2); \
    VRD(3); SBAR(); GAPA(C0=__builtin_amdgcn_mfma_f32_32x32x16_bf16(kf[6],qr[3],C0,0,0,0),   P1[10],P1[11],P1[12],P1[13], pw3[0]=PKW(P1,8), pw3[1]=PKW(P1,10), pw3); \
    VRD(7); SBAR(); GAPA(C1=__builtin_amdgcn_mfma_f32_32x32x16_bf16(kf[7],qr[3],C1,0,0,0),   P1[14],P1[15],0.f,0.f,       pw3[2]=PKW(P1,12),pw3[3]=PKW(P1,14), pw3); \
    l_reg+=sacc; \
    if(GK){DMA_K((t)+3,sl_cur);} if(GV){DMA_V((t)+1,sl_next);} \
    CMASK(C0,C1,t); \
    if constexpr(THRL<1000){ float a=MX3(C0[0],C0[1],C1[0]),b=MX3(C0[2],C0[3],C1[1]); a=MX3(a,C1[2],C1[3]); \
      _Pragma("unroll") for(int r=4;r<16;r+=4){a=MX3(a,C0[r],C0[r+1]);b=MX3(b,C0[r+2],C0[r+3]);a=MX3(a,C1[r],C1[r+1]);b=MX3(b,C1[r+2],C1[r+3]);} \
      float rm=__builtin_fmaxf(a,b); { auto rr=__builtin_amdgcn_permlane32_swap(__float_as_uint(rm),__float_as_uint(rm),false,false); rm=__builtin_fmaxf(__uint_as_float(rr[0]),__uint_as_float(rr[1])); } \
      resc=false; \
      if(__builtin_expect(__any(rm>(float)THRL),0)){ const float dl=__builtin_fmaxf(rm,0.f); mhat+=dl; \
        _Pragma("unroll") for(int r=0;r<16;++r){C0[r]-=dl;C1[r]-=dl;} \
        _Pragma("unroll") for(int r=0;r<16;++r)negm[r]=-mhat; asm volatile("":"+v"(negm)); \
        const float f=__builtin_amdgcn_exp2f(-dl); l_reg*=f; if(hi==0)wsf[r32]=f; resc=true; } } \
    SBAR(); \
    GAPB(o[0]=__builtin_amdgcn_mfma_f32_32x32x16_bf16(PAF(0),VFR(0),o[0],0,0,0), C0,0); \
    GAPB(o[1]=__builtin_amdgcn_mfma_f32_32x32x16_bf16(PAF(0),VFR(4),o[1],0,0,0), C0,4); \
    KRD(GL,0); GAPB(o[0]=__builtin_amdgcn_mfma_f32_32x32x16_bf16(PAF(1),VFR(1),o[0],0,0,0), C0,8); \
    KRD(GL,1); GAPB(o[1]=__builtin_amdgcn_mfma_f32_32x32x16_bf16(PAF(1),VFR(5),o[1],0,0,0), C0,12); \
    KRD(GL,2); GAPB(o[0]=__builtin_amdgcn_mfma_f32_32x32x16_bf16(PAF(2),VFR(2),o[0],0,0,0), C1,0); \
    KRD(GL,3); GAPB(o[1]=__builtin_amdgcn_mfma_f32_32x32x16_bf16(PAF(2),VFR(6),o[1],0,0,0), C1,4); \
    GAPB(o[0]=__builtin_amdgcn_mfma_f32_32x32x16_bf16(PAF(3),VFR(3),o[0],0,0,0), C1,8); \
    GAPB(o[1]=__builtin_amdgcn_mfma_f32_32x32x16_bf16(PAF(3),VFR(7),o[1],0,0,0), C1,12); \
    }while(0)
  int t=1;
  #undef CMASK
  #define CMASK(P0,P1,t) do{}while(0)
  for(;t+5<NT;t+=2){
    STEP(pB0,pB1,pA0,pA1,t,true,true,true);     WAIT_BAR(2); RESC(); ROT();
    STEP(pA0,pA1,pB0,pB1,t+1,true,true,true);   WAIT_BAR(2); RESC(); ROT();
  }
  #undef CMASK
  #define CMASK(P0,P1,t) do{}while(0)
  #define ENDW(tt) do{ if((tt)+3<NT){WAIT_BAR(2);} else if((tt)+2<NT){WAIT_BAR(1);} else {WAIT_BAR(0);} }while(0)
  for(;t+1<NT;t+=2){
    STEP(pB0,pB1,pA0,pA1,t,(t+3<NT),(t+1<NT),(t+1<NT));       ENDW(t);   RESC(); ROT();
    STEP(pA0,pA1,pB0,pB1,t+1,(t+4<NT),(t+2<NT),(t+2<NT));     ENDW(t+1); RESC(); ROT();
  }
  STEP(pB0,pB1,pA0,pA1,NT-1,false,false,false); RESC();
  { float sacc=pB0[0]+pB0[1]; _Pragma("unroll") for(int r=2;r<16;++r)sacc+=pB0[r]; _Pragma("unroll") for(int r=0;r<16;++r)sacc+=pB1[r]; l_reg+=sacc;
    pw0=(u32x4){PKW(pB0,0),PKW(pB0,2),PKW(pB0,4),PKW(pB0,6)};pw1=(u32x4){PKW(pB0,8),PKW(pB0,10),PKW(pB0,12),PKW(pB0,14)};pw2=(u32x4){PKW(pB1,0),PKW(pB1,2),PKW(pB1,4),PKW(pB1,6)};pw3=(u32x4){PKW(pB1,8),PKW(pB1,10),PKW(pB1,12),PKW(pB1,14)};
    SBAR(); pv(o,vb0+sl_cur,PAF(0),PAF(1),PAF(2),PAF(3)); }
  #undef PKW
  #undef PAF
  #undef VFR
  #undef PIN
  #undef MX3
  #undef GAPA
  #undef GAPB
  #undef EX
  #undef VRD
  #undef KRD
  #undef STEP
  #undef ENDW
  {auto rr=__builtin_amdgcn_permlane32_swap(__float_as_uint(l_reg),__float_as_uint(l_reg),false,false);l_reg=__uint_as_float(rr[0])+__uint_as_float(rr[1]);}
  if(hi==0)wsf[32+r32]=l_reg;asm volatile("s_waitcnt lgkmcnt(0)":::"memory");
  float rli[16];
  #pragma unroll
  for(int r=0;r<16;++r)rli[r]=__builtin_amdgcn_rcpf(wsf[32+crow(r,hi)]);
  bf16*Ow=Ou+(long)(wid*QBLK)*OPI;
  { bf16*stg=(bf16*)(shm+LDS_OST)+wid*2048;
    #pragma unroll
    for(int r=0;r<16;++r){const int orow=crow(r,hi);
      #pragma unroll
      for(int d0=0;d0<2;++d0)stg[orow*64+d0*32+r32]=__float2bfloat16(o[d0][r]*rli[r]);}
    asm volatile("s_waitcnt lgkmcnt(0)":::"memory");
    #pragma unroll
    for(int i=0;i<4;++i){const int row=i*8+(lane>>3),ch=lane&7; const u32x4 v=*(const u32x4*)(stg+row*64+ch*8); ATTN_STORE16(Ow+(long)row*OPI+ch*8,v);} }
  asm volatile("s_waitcnt lgkmcnt(0)\n\ts_barrier":::"memory");
  __builtin_amdgcn_s_setprio(0);
  #undef DMA_K
  #undef DMA_V
  #undef CMASK
  #undef START
  #undef RESC
  #undef ROT
}
constexpr int ATTN_LDS_BYTES=LDS_BYTES;
#undef SBAR
#undef WAIT_BAR
}

__device__ __forceinline__ void ph_attn(const Prm& p, int l, char* shm) {
    using attn_body::bf16;
    unsigned char* ws = p.ws;
    const bf16* QP = (const bf16*)(ws + O_QP); const bf16* KP = (const bf16*)(ws + O_KP); const bf16* PM = (const bf16*)(ws + O_PM); bf16* MIX = (bf16*)(ws + O_MIX);
    const int nunits = 1024 + ((l == NLAYER - 1) ? 0 : 128);
    for (int L = bid_(); L < nunits; L += nblk_()) {
        int b, h, g, nt; long qrow0, krow0;
        if (L < 1024) { const int i = L >> 8, cc = L & 255, xcd = cc & 7, slot = cc >> 3, id = i * 8 + xcd; b = id >> 1; g = id & 1; h = g * 4 + (slot >> 3); qrow0 = (long)b * TPB + (slot & 7) * 256; krow0 = (long)b * TPB; nt = 36; }
        else { const int j = L - 1024; b = j >> 3; h = j & 7; g = h >> 2; qrow0 = (long)b * TPB + LSEQ; krow0 = qrow0; nt = 4; }
        attn_body::attn_unit<8, 512, 128, PMW, DM>(QP + qrow0 * 512 + h * 64, KP + krow0 * 128 + g * 64, PM + krow0 * PMW + 640 + g * 64, MIX + qrow0 * DM + h * 64, nt, shm);
    }
}

template <int N, int TT, int BB, int TP>
__device__ __forceinline__ void hyena_unit(const Prm& p, int l, int ch, LAS unsigned char* lds) {
    const int tid = tid_(); unsigned char* ws = p.ws; constexpr bool LAT = (N == LSEQ);
    const bf16_t* hyt = LAT ? (const bf16_t*)(ws + O_HYT) : (const bf16_t*)(ws + O_HYTC);
    const bf16_t* gf = LAT ? (const bf16_t*)(ws + O_GFL) + (size_t)l * 512 * 4096 : (const bf16_t*)(ws + O_GFC) + (size_t)l * 512 * 512;
    bf16_t* MIX = (bf16_t*)(ws + O_MIX);
    LAS float* Gs = (LAS float*)lds;
    LAS bf16_t* Z0 = (LAS bf16_t*)(lds + 2 * N * 4);
    LAS bf16_t* Z1 = Z0 + N * 16;
    const float* sw = p.hy_sw + (size_t)l * 3 * 768; const float* sb = p.hy_sb + (size_t)l * 768;
    auto sconv = [&](int part, int b, int t) -> float {
        const int c = part * 256 + ch; const bf16_t* row = hyt + ((size_t)c * NBATCH + b) * N;
        float a = sb[c] + sw[768 + c] * bf2f(row[t]);
        if (t > 0) a += sw[c] * bf2f(row[t - 1]);
        if (t < N - 1) a += sw[2 * 768 + c] * bf2f(row[t + 1]);
        return a; };
    __syncthreads();
    for (int e = tid; e < N * 16; e += NT) { const int b = e / N, t = e % N; Z0[t * 16 + b] = (bf16_t)f2bf(sconv(0, b, t)); }
#pragma unroll 1
    for (int order = 0; order < 2; ++order) {
        __syncthreads();
        const bf16_t* grow = gf + ((size_t)order * 256 + ch) * (2 * N);
        for (int e = tid; e < 2 * N; e += NT) Gs[e] = bf2f(grow[e]);
        __syncthreads();
        LAS bf16_t* Zin = order ? Z1 : Z0; LAS bf16_t* Zout = order ? Z0 : Z1;
        const int b0 = (N == LSEQ) ? 0 : (tid >> 8) * 8;
#pragma unroll 1
        for (int tp = 0; tp < TP; ++tp) {
        int tt[TT];
#pragma unroll
        for (int i = 0; i < TT; ++i) tt[i] = LAT ? tid + NT * (tp * TT + i) : (tid & 255);
        float acc[TT][BB];
#pragma unroll
        for (int i = 0; i < TT; ++i)
#pragma unroll
            for (int j = 0; j < BB; ++j) acc[i][j] = 0.f;
#pragma unroll 1
        for (int s = 0; s < N; ++s) {
            float z[BB];
#pragma unroll
            for (int j = 0; j < BB; j += 8) { const u32x4 raw = *(const LAS u32x4*)(Zin + s * 16 + b0 + j);
                z[j] = bflo(raw.x); z[j + 1] = bfhi(raw.x); z[j + 2] = bflo(raw.y); z[j + 3] = bfhi(raw.y); z[j + 4] = bflo(raw.z); z[j + 5] = bfhi(raw.z); z[j + 6] = bflo(raw.w); z[j + 7] = bfhi(raw.w); }
#pragma unroll
            for (int i = 0; i < TT; ++i) { const float gv = Gs[s - tt[i] + N - 1];
#pragma unroll
                for (int j = 0; j < BB; ++j) acc[i][j] += gv * z[j]; }
        }
        const float dskip = p.hy_bias[((size_t)l * 2 + order) * 256 + ch];
#pragma unroll
        for (int i = 0; i < TT; ++i)
#pragma unroll
            for (int j = 0; j < BB; ++j) { const int b = b0 + j, t = tt[i]; const float zin = bf2f(Zin[t * 16 + b]); const float gate = sconv(1 + order, b, t);
                const float y = gate * (acc[i][j] + dskip * zin);
                if (order == 0) Zout[t * 16 + b] = (bf16_t)f2bf(y);
                else MIX[((size_t)b * TPB + (LAT ? 0 : LSEQ) + t) * DM + 512 + ch] = (bf16_t)f2bf(y);
                asm volatile("" ::: "memory"); }
        }
    }
}
__device__ __forceinline__ void ph_hyena_naive(const Prm& p, int l, LAS unsigned char* lds) {
    const int nunits = (l == NLAYER - 1) ? 256 : 512;
    for (int u = bid_(); u < nunits; u += nblk_()) {
        if (u < 256) hyena_unit<LSEQ, 2, 16, 2>(p, l, u, lds); else hyena_unit<LCTX, 1, 8, 1>(p, l, u - 256, lds);
    }
}


constexpr int HY_C1 = 8192 + 64;
constexpr int HY_Z = 20480;
template <int N, int ROWT, bool INPLACE = false>
__device__ __forceinline__ void hyena_mfma_unit(const Prm& p, int l, int ch, LAS unsigned char* lds, int zoff = HY_Z) {
    constexpr int NJ = N / 32, W = ROWT, UN = W / 2; constexpr bool LAT = (N == LSEQ);
    const int tid = tid_(), lane = tid & 63, wid = tid >> 6, fr = lane & 15, fq = lane >> 4; unsigned char* ws = p.ws;
    const bf16_t* hyt = LAT ? (const bf16_t*)(ws + O_HYT) : (const bf16_t*)(ws + O_HYTC);
    const bf16_t* gf = LAT ? (const bf16_t*)(ws + O_GFL) + (size_t)l * 512 * 4096 : (const bf16_t*)(ws + O_GFC) + (size_t)l * 512 * 512;
    bf16_t* MIX = (bf16_t*)(ws + O_MIX);
    const float* sw = p.hy_sw + (size_t)l * 3 * 768; const float* sb = p.hy_sb + (size_t)l * 768;
    LAS unsigned char* Zc = lds + zoff;
    __syncthreads();
    { const int c = ch; const float w0 = sw[c], w1 = sw[768 + c], w2 = sw[2 * 768 + c], bb = sb[c];
      constexpr int NI = (N / 8) * 16 / NT > 0 ? (N / 8) * 16 / NT : 1;
      const bf16_t* hb = hyt + (size_t)c * NBATCH * N; u32x4 raw[NI]; bf16_t lo[NI], hi[NI];
#pragma unroll
      for (int q = 0; q < NI; ++q) { const int item = tid + q * NT; const bool ok = item < (N / 8) * 16; const int chunk = item >> 4, b = item & 15, t0 = chunk * 8; const unsigned o = (unsigned)(b * N + t0);
          const int oc_ = ok ? (int)o : 8; raw[q] = *(const u32x4*)(hb + oc_); lo[q] = hb[oc_ - 1]; hi[q] = hb[oc_ + 8]; }
#pragma unroll
      for (int q = 0; q < NI; ++q) { const int item = tid + q * NT; if (item < (N / 8) * 16) { float u[10];
          const int t0_ = (item >> 4) * 8; u[0] = bf2f(lo[q]) * (t0_ > 0 ? 1.f : 0.f); u[9] = bf2f(hi[q]) * (t0_ + 8 < N ? 1.f : 0.f);
          u[1] = bflo(raw[q].x); u[2] = bfhi(raw[q].x); u[3] = bflo(raw[q].y); u[4] = bfhi(raw[q].y); u[5] = bflo(raw[q].z); u[6] = bfhi(raw[q].z); u[7] = bflo(raw[q].w); u[8] = bfhi(raw[q].w);
          float o[8];
#pragma unroll
          for (int k = 0; k < 8; ++k) o[k] = bb + w0 * u[k] + w1 * u[k + 1] + w2 * u[k + 2];
          *(LAS u32x4*)(Zc + item * 16) = (u32x4){pk2(o[0], o[1]), pk2(o[2], o[3]), pk2(o[4], o[5]), pk2(o[6], o[7])}; } } }
    const int tw = ROWT * 16 * wid, c0 = 8 * fq - fr + (N - 1) - tw, par = c0 & 1;
    const LAS unsigned char* tp = lds + (par ? HY_C1 : 0) + (c0 - par) * 2;
#pragma unroll 1
    for (int order = 0; order < 2; ++order) {
        __syncthreads();
        { const unsigned* g32 = (const unsigned*)(gf + ((size_t)order * 256 + ch) * (2 * N));
          constexpr int ND = N / NT > 0 ? N / NT : 1; unsigned ga[ND], gb[ND];
#pragma unroll
          for (int q = 0; q < ND; ++q) { const int d = tid + q * NT; ga[q] = d < N ? g32[d] : 0u; gb[q] = (d + 1 < N) ? g32[d + 1] : 0u; }
#pragma unroll
          for (int q = 0; q < ND; ++q) { const int d = tid + q * NT; if (d < N) { *(LAS unsigned*)(lds + d * 4) = ga[q]; *(LAS unsigned*)(lds + HY_C1 + d * 4) = (ga[q] >> 16) | (gb[q] << 16); } } }
        __syncthreads();
        f32x4 acc[ROWT];
#pragma unroll
        for (int i = 0; i < ROWT; ++i) acc[i] = (f32x4){0.f, 0.f, 0.f, 0.f};
        u32x4 Tw[W];
#pragma unroll
        for (int d = 1 - W; d <= 0; ++d) { const LAS unsigned* q = (const LAS unsigned*)(tp + 32 * d); Tw[(d + W) % W] = (u32x4){q[0], q[1], q[2], q[3]}; }
        bf16x8 zf = *(const LAS bf16x8*)(Zc + ((4 * 0 + fq) * 16 + fr) * 16);
#pragma unroll 1
        for (int j0 = 0; j0 < NJ; j0 += UN) {
#pragma unroll
            for (int r = 0; r < UN; ++r) {
                const int j = j0 + r;
#pragma unroll
                for (int it = ROWT - 1; it >= (ROWT >= 2 ? ROWT - 2 : 0); --it)
                    acc[it] = __builtin_amdgcn_mfma_f32_16x16x32_bf16(__builtin_bit_cast(bf16x8, Tw[(2 * r - it + 4 * W) % W]), zf, acc[it], 0, 0, 0);
                { const LAS unsigned* q = (const LAS unsigned*)(tp + 32 * (2 * j + 1)); Tw[(2 * r + 1) % W] = (u32x4){q[0], q[1], q[2], q[3]}; }
                { const LAS unsigned* q = (const LAS unsigned*)(tp + 32 * (2 * j + 2)); Tw[(2 * r + 2) % W] = (u32x4){q[0], q[1], q[2], q[3]}; }
                const bf16x8 zn = *(const LAS bf16x8*)(Zc + ((4 * ((j + 1) & (NJ - 1)) + fq) * 16 + fr) * 16);
#pragma unroll
                for (int it = ROWT - 3; it >= 0; --it)
                    acc[it] = __builtin_amdgcn_mfma_f32_16x16x32_bf16(__builtin_bit_cast(bf16x8, Tw[(2 * r - it + 4 * W) % W]), zf, acc[it], 0, 0, 0);
                zf = zn;
                __builtin_amdgcn_sched_barrier(0);
            }
        }
        __syncthreads();
        const int part = 1 + order, cg = part * 256 + ch; const float w0 = sw[cg], w1 = sw[768 + cg], w2 = sw[2 * 768 + cg], bb = sb[cg];
        const float dskip = p.hy_bias[((size_t)l * 2 + order) * 256 + ch];
        const bf16_t* ub = hyt + (size_t)cg * NBATCH * N;
        unsigned uoff = (unsigned)(fr * N + tw + 4 * fq); asm volatile("" : "+v"(uoff));
        bf16_t* mb = MIX + 512 + ch; unsigned moff = (unsigned)((fr * TPB + (LAT ? 0 : LSEQ) + tw + 4 * fq) * DM); asm volatile("" : "+v"(moff));
        u32x2 mid[ROWT]; bf16_t ulo[ROWT], uhi[ROWT];
#pragma unroll
        for (int it = 0; it < ROWT; ++it) { const int t4 = tw + 16 * it + 4 * fq; const unsigned uo = uoff + 16u * it;
            mid[it] = *(const u32x2*)(ub + uo); ulo[it] = ub[(int)uo - 1]; uhi[it] = ub[(int)uo + 4]; }
#pragma unroll
        for (int it = 0; it < ROWT; ++it) {
            const int t4 = tw + 16 * it + 4 * fq; float u[6];
            u[0] = bf2f(ulo[it]) * (t4 > 0 ? 1.f : 0.f); u[5] = bf2f(uhi[it]) * (t4 + 4 < N ? 1.f : 0.f); u[1] = bflo(mid[it].x); u[2] = bfhi(mid[it].x); u[3] = bflo(mid[it].y); u[4] = bfhi(mid[it].y);
            LAS u32x2* zp = (LAS u32x2*)(Zc + (((t4 >> 3) * 16 + fr) * 8 + (t4 & 7)) * 2); const u32x2 zin = *zp;
            const float z0 = bflo(zin.x), z1 = bfhi(zin.x), z2 = bflo(zin.y), z3 = bfhi(zin.y); float y[4];
            y[0] = (bb + w0 * u[0] + w1 * u[1] + w2 * u[2]) * (acc[it][0] + dskip * z0); y[1] = (bb + w0 * u[1] + w1 * u[2] + w2 * u[3]) * (acc[it][1] + dskip * z1);
            y[2] = (bb + w0 * u[2] + w1 * u[3] + w2 * u[4]) * (acc[it][2] + dskip * z2); y[3] = (bb + w0 * u[3] + w1 * u[4] + w2 * u[5]) * (acc[it][3] + dskip * z3);
            if (order == 0 || INPLACE) { u32x2 o; o.x = pk2(y[0], y[1]); o.y = pk2(y[2], y[3]); *zp = o; }
            else { const unsigned mo = moff + (unsigned)(16 * it * DM);
#pragma unroll
                for (int r = 0; r < 4; ++r) mb[mo + (unsigned)(r * DM)] = (bf16_t)f2bf(y[r]); }
        }
    }
}
__device__ __forceinline__ void hyena_pair_unit(const Prm& p, int l, int ch0, LAS unsigned char* lds) {
    hyena_mfma_unit<LSEQ, 16, true>(p, l, ch0, lds, HY_Z);
    hyena_mfma_unit<LSEQ, 16, true>(p, l, ch0 + 1, lds, HY_Z + 65536);
    __syncthreads();
    const int tid = tid_(); bf16_t* mb = (bf16_t*)(p.ws + O_MIX) + 512 + ch0;
#pragma unroll 1
    for (int q = 0; q < 8; ++q) { const int item = tid + q * NT, chunk = item >> 4, b = item & 15;
        const u32x4 a = *(const LAS u32x4*)(lds + HY_Z + item * 16), c = *(const LAS u32x4*)(lds + HY_Z + 65536 + item * 16);
        unsigned* o = (unsigned*)(mb + (size_t)(b * TPB + chunk * 8) * DM);
        o[0 * (DM / 2)] = (a.x & 0xffffu) | (c.x << 16);          o[1 * (DM / 2)] = (a.x >> 16) | (c.x & 0xffff0000u);
        o[2 * (DM / 2)] = (a.y & 0xffffu) | (c.y << 16);          o[3 * (DM / 2)] = (a.y >> 16) | (c.y & 0xffff0000u);
        o[4 * (DM / 2)] = (a.z & 0xffffu) | (c.z << 16);          o[5 * (DM / 2)] = (a.z >> 16) | (c.z & 0xffff0000u);
        o[6 * (DM / 2)] = (a.w & 0xffffu) | (c.w << 16);          o[7 * (DM / 2)] = (a.w >> 16) | (c.w & 0xffff0000u); }
}
__device__ __forceinline__ void ph_hyena(const Prm& p, int l, LAS unsigned char* lds) {
    const int nunits = (l == NLAYER - 1) ? 256 : 512;
    for (int u = bid_(); u < nunits; u += nblk_()) {
        if (u < 256) hyena_mfma_unit<LSEQ, 16>(p, l, u, lds); else hyena_mfma_unit<LCTX, 2>(p, l, u - 256, lds);
    }
}

__device__ __forceinline__ void ph_norm2(const Prm& p, int l, LAS unsigned char* lds) {
    const int tid = tid_(), lane = tid & 63, wv = tid >> 6; unsigned char* ws = p.ws;
    const bf16_t* xs = (const bf16_t*)(ws + O_XS); unsigned char* H8 = (unsigned char*)(ws + O_H); const float* modv = (const float*)(ws + O_MODV); float* aff = (float*)(ws + O_AFF);
    const float* wr = p.w_router + (size_t)l * DM * NEXP;
    __syncthreads();
    for (int i = tid; i < DM * 4; i += NT) { const int k = i >> 2, e4 = i & 3; const int rowp = (k & 3) * 256 + (k >> 2); *(LAS f32x4*)(lds + rowp * 80 + e4 * 16) = *(const f32x4*)(wr + (size_t)k * 16 + e4 * 4); }
    __syncthreads();
    LAS float* mv = (LAS float*)(lds + 1024 * 80);
    const int rpb = (((NTOK + nblk_() - 1) / nblk_()) + 1) & ~1; const int i0 = bid_() * rpb; const int i1 = (i0 + rpb < NTOK) ? i0 + rpb : NTOK;
    u32x2 nv[2][4]; u32x2 ny[2][4]; const bf16_t* Y16 = (const bf16_t*)(ws + O_MIX);
#pragma unroll 1
    for (int s0 = i0; s0 < i1; ) {
      const int b = s0 / TPB, t0 = s0 % TPB; const bool isctx = t0 >= LSEQ; const int mrow = isctx ? 16 : b;
      const int segend = b * TPB + (isctx ? TPB : LSEQ); const int s1 = segend < i1 ? segend : i1;
      if (isctx && l == NLAYER - 1) { s0 = s1; continue; }
      __syncthreads();
      { const float* ml = modv + ((size_t)l * 17 + mrow) * 6144;
        for (int i = tid; i < 768; i += NT) { const int which = i >> 8, c = (i & 255) * 4; f32x4 val;
            if (which == 0) val = *(const f32x4*)(ml + 2 * 1024 + c);
            else if (which == 1) val = *(const f32x4*)(p.norm2_g + l * DM + c) * (*(const f32x4*)(ml + 4 * 1024 + c) + 1.0f);
            else val = *(const f32x4*)(ml + 3 * 1024 + c);
            *(LAS f32x4*)(mv + which * 1024 + c) = val; } }
      __syncthreads();
      int r = s0 + wv * 2;
      if (r < s1) {
#pragma unroll
        for (int rr = 0; rr < 2; ++rr)
#pragma unroll
            for (int q = 0; q < 4; ++q) { nv[rr][q] = *(const u32x2*)(xs + (size_t)(r + rr) * DM + q * 256 + lane * 4); ny[rr][q] = *(const u32x2*)(Y16 + (size_t)(r + rr) * DM + q * 256 + lane * 4); } }
#pragma unroll 1
      for (; r < s1; r += 16) {
        f32x4 v[2][4]; float ss[2] = {0.f, 0.f};
#pragma unroll
        for (int q = 0; q < 4; ++q) { const f32x4 g1 = *(const LAS f32x4*)(mv + q * 256 + lane * 4);
#pragma unroll
            for (int rr = 0; rr < 2; ++rr) { f32x4 w = {bflo(nv[rr][q].x), bfhi(nv[rr][q].x), bflo(nv[rr][q].y), bfhi(nv[rr][q].y)}; w[0] += g1[0] * bflo(ny[rr][q].x); w[1] += g1[1] * bfhi(ny[rr][q].x); w[2] += g1[2] * bflo(ny[rr][q].y); w[3] += g1[3] * bfhi(ny[rr][q].y);
                v[rr][q] = w; ss[rr] += w[0] * w[0] + w[1] * w[1] + w[2] * w[2] + w[3] * w[3]; } }
        if (r + 16 < s1) {
#pragma unroll
            for (int rr = 0; rr < 2; ++rr)
#pragma unroll
                for (int q = 0; q < 4; ++q) { nv[rr][q] = *(const u32x2*)(xs + (size_t)(r + 16 + rr) * DM + q * 256 + lane * 4); ny[rr][q] = *(const u32x2*)(Y16 + (size_t)(r + 16 + rr) * DM + q * 256 + lane * 4); } }
        float rstd[2];
#pragma unroll
        for (int rr = 0; rr < 2; ++rr) { const float s_ = wave_sum(ss[rr]); rstd[rr] = rsqrtf(s_ * (1.0f / DM) + EPS); }
        __builtin_amdgcn_sched_barrier(0);
        asm volatile("" : "+v"(rstd[0]), "+v"(rstd[1]));
        f32x4 h[2][4];
#pragma unroll
        for (int q = 0; q < 4; ++q) { const int c = q * 256 + lane * 4;
            const f32x4 ga = *(const LAS f32x4*)(mv + 1024 + c), sh = *(const LAS f32x4*)(mv + 2048 + c);
#pragma unroll
            for (int rr = 0; rr < 2; ++rr) { h[rr][q] = (v[rr][q] * rstd[rr]) * ga + sh; *(unsigned*)(H8 + (size_t)(r + rr) * DM + c) = pk4_fp8(h[rr][q][0], h[rr][q][1], h[rr][q][2], h[rr][q][3]); } }
        __builtin_amdgcn_sched_barrier(0);
        typedef float f2_ __attribute__((ext_vector_type(2))); f2_ lg[16]; unsigned wofs = (unsigned)lane * 80u;        asm volatile("" : "+v"(wofs));
#pragma unroll
        for (int e = 0; e < 16; ++e) lg[e] = (f2_){0.f, 0.f};
#pragma unroll
        for (int q = 0; q < 4; ++q) {
#pragma unroll
            for (int j = 0; j < 4; ++j) { const LAS unsigned char* wrow = lds + (j * 256 + q * 64) * 80 + wofs;
                f32x4 w[4];
#pragma unroll
                for (int e4 = 0; e4 < 4; ++e4) w[e4] = *(const LAS f32x4*)(wrow + e4 * 16);
#pragma unroll
                for (int e4 = 0; e4 < 4; ++e4) { const f2_ hp = {h[0][q][j], h[1][q][j]};
#pragma unroll
                    for (int k = 0; k < 4; ++k) lg[e4 * 4 + k] += hp * (f2_){w[e4][k], w[e4][k]}; }
                __builtin_amdgcn_sched_barrier(0);
            } }
        asm volatile("" : "+v"(lg[0]), "+v"(lg[1]), "+v"(lg[2]), "+v"(lg[3]), "+v"(lg[4]), "+v"(lg[5]), "+v"(lg[6]), "+v"(lg[7]));
        asm volatile("" : "+v"(lg[8]), "+v"(lg[9]), "+v"(lg[10]), "+v"(lg[11]), "+v"(lg[12]), "+v"(lg[13]), "+v"(lg[14]), "+v"(lg[15]));
#pragma unroll
        for (int rr = 0; rr < 2; ++rr) {
        float r8[8], r4[4], r2[2], r1;
        { const bool up = (lane & 32) != 0;
#pragma unroll
          for (int i = 0; i < 8; ++i) { const float keep = up ? lg[8 + i][rr] : lg[i][rr], give = up ? lg[i][rr] : lg[8 + i][rr]; r8[i] = keep + __shfl_xor(give, 32); } }
        { const bool up = (lane & 16) != 0;
#pragma unroll
          for (int i = 0; i < 4; ++i) { const float keep = up ? r8[4 + i] : r8[i], give = up ? r8[i] : r8[4 + i]; r4[i] = keep + __shfl_xor(give, 16); } }
        { const bool up = (lane & 8) != 0;
#pragma unroll
          for (int i = 0; i < 2; ++i) { const float keep = up ? r4[2 + i] : r4[i], give = up ? r4[i] : r4[2 + i]; r2[i] = keep + __shfl_xor(give, 8); } }
        { const bool up = (lane & 4) != 0; const float keep = up ? r2[1] : r2[0], give = up ? r2[0] : r2[1]; r1 = keep + __shfl_xor(give, 4); }
        r1 += __shfl_xor(r1, 2); r1 += __shfl_xor(r1, 1);
        float mxv = r1;
        mxv = fmaxf(mxv, __shfl_xor(mxv, 32)); mxv = fmaxf(mxv, __shfl_xor(mxv, 16)); mxv = fmaxf(mxv, __shfl_xor(mxv, 8)); mxv = fmaxf(mxv, __shfl_xor(mxv, 4));
        const float ex = expf(r1 - mxv); float den = ex;
        den += __shfl_xor(den, 32); den += __shfl_xor(den, 16); den += __shfl_xor(den, 8); den += __shfl_xor(den, 4);
        const int e = ((lane >> 5) & 1) * 8 + ((lane >> 4) & 1) * 4 + ((lane >> 3) & 1) * 2 + ((lane >> 2) & 1);
        if ((lane & 3) == 0) aff[(size_t)(r + rr) * 16 + e] = ex / den;
        __builtin_amdgcn_sched_barrier(0);
        }
      }
      s0 = s1;
    }
}

__device__ __forceinline__ void ph_topk(const Prm& p, int l, LAS unsigned char* lds) {
    const int tid = tid_(); unsigned char* ws = p.ws;
    const float* aff = (const float*)(ws + O_AFF); int* sel = (int*)(ws + O_SEL); int* idx = (int*)(ws + O_IDX);
    LAS unsigned long long* key = (LAS unsigned long long*)lds;
    const int nunits = (l == NLAYER - 1) ? 256 : 512;
    for (int u = bid_(); u < nunits; u += nblk_()) {
        const bool isctx = u >= 256; const int b = (u & 255) >> 4, e = u & 15; const int n = isctx ? LCTX : LSEQ, cap = isctx ? CAP_C : CAP_L; const int row0 = b * TPB + (isctx ? LSEQ : 0);
        __syncthreads();
        for (int t = tid; t < n; t += NT) key[t] = ((unsigned long long)__float_as_uint(aff[(size_t)(row0 + t) * 16 + e]) << 32) | (unsigned)(0xffffffffu - (unsigned)t);
        __syncthreads();
        const int SEG = n >> 3, wv_ = tid >> 6, ln_ = tid & 63;
        for (int k = 2; k <= n; k <<= 1) {
            for (int j = k >> 1; j > 0; j >>= 1) {
                if (j >= SEG) {
                    __syncthreads();
                    for (int q = tid; q < (n >> 1); q += NT) {
                        const int i = ((q & ~(j - 1)) << 1) | (q & (j - 1)), ix = i | j;
                        const unsigned long long a = key[i], c = key[ix]; const bool desc = ((i & k) == 0);
                        if ((a < c) == desc) { key[i] = c; key[ix] = a; }
                    }
                    if (j == SEG) __syncthreads();
                } else {
                    for (int q = ln_; q < (SEG >> 1); q += 64) {
                        const int i = wv_ * SEG + (((q & ~(j - 1)) << 1) | (q & (j - 1))), ix = i | j;
                        const unsigned long long a = key[i], c = key[ix]; const bool desc = ((i & k) == 0);
                        if ((a < c) == desc) { key[i] = c; key[ix] = a; }
                    }
                    asm volatile("s_waitcnt lgkmcnt(0)" ::: "memory");
                }
            }
        }
        __syncthreads();
        for (int r = tid; r < n; r += NT) { const int t = (int)(0xffffffffu - (unsigned)key[r]);
            const int slot = isctx ? (4096 + b * CAP_C + r) : (b * CAP_L + r);
            if (r < cap) { idx[e * EROWS + slot] = row0 + t; sel[(size_t)(row0 + t) * 16 + e] = slot; } else sel[(size_t)(row0 + t) * 16 + e] = -1; }
        { const unsigned char* H8 = (const unsigned char*)(ws + O_H); unsigned char* XG = (unsigned char*)(ws + O_XG8) + ((size_t)e * EROWS + (isctx ? (4096 + b * CAP_C) : (b * CAP_L))) * DM;
          const int lane = tid & 63, wv = tid >> 6;
          if (isctx) { const int r0 = wv * 4; u32x4 v[4];
#pragma unroll
              for (int q = 0; q < 4; ++q) { const int t = (int)(0xffffffffu - (unsigned)key[r0 + q]); v[q] = *(const u32x4*)(H8 + (size_t)(row0 + t) * DM + lane * 16); }
#pragma unroll
              for (int q = 0; q < 4; ++q) *(u32x4*)(XG + (size_t)(r0 + q) * DM + lane * 16) = v[q]; }
          else {
#pragma unroll 1
              for (int r0 = wv * 16; r0 < cap; r0 += 128) { u32x4 v[16];
#pragma unroll
                  for (int q = 0; q < 16; ++q) { const int t = (int)(0xffffffffu - (unsigned)key[r0 + q]); v[q] = *(const u32x4*)(H8 + (size_t)(row0 + t) * DM + lane * 16); }
#pragma unroll
                  for (int q = 0; q < 16; ++q) *(u32x4*)(XG + (size_t)(r0 + q) * DM + lane * 16) = v[q]; } } }
    }
}

struct SchedG1a { const bf16_t *H, *WM; int g, c, lat;
    __device__ __forceinline__ bool next(int i, GU& u) const { int pm, pn; const int L = i * g + c;
        if (!lat) { if (!tile_order(L, 144, 3, pm, pn)) return false; }
        else if (L < 128 * 3) { tile_order(L, 128, 3, pm, pn); pm = (pm >> 3) * 9 + (pm & 7); }
        else if (L < 128 * 3 + 16) { pm = (L - 128 * 3) * 9 + 8; pn = 2; }
        else return false;
        u.gidx = nullptr; u.lda = 512; u.ldb = 512; u.nt = 8; u.A = H + (size_t)pm * BM * 512; u.B = WM + (size_t)pn * BM * 512; u.i0 = pm; u.i1 = pn; u.i2 = 0; u.i3 = 0; return true; } };
struct SchedG1g { const bf16_t *H8, *WG; int g, c, lat;
    __device__ __forceinline__ bool next(int i, GU& u) const { int pm, pn; if (!tile_order(i * g + c, lat ? 128 : 144, 12, pm, pn)) return false;
        if (lat) pm = (pm >> 3) * 9 + (pm & 7);
        u.gidx = nullptr; u.lda = 512; u.ldb = 512; u.nt = 8; u.A = H8 + (size_t)pm * BM * 512; u.B = WG + (size_t)pn * BM * 512; u.i0 = pm; u.i1 = pn; u.i2 = 0; u.i3 = 0; return true; } };
struct SchedG1b { const bf16_t *H, *WS; int g, c, lat;
    __device__ __forceinline__ bool next(int i, GU& u) const { int pn, pm; if (!tile_order(i * g + c, 5, lat ? 128 : 144, pn, pm)) return false;
        if (lat) pm = (pm >> 3) * 9 + (pm & 7);
        u.gidx = nullptr; u.lda = DM; u.ldb = DM; u.nt = 16; u.A = WS + (size_t)pn * BM * DM; u.B = H + (size_t)pm * BM * DM; u.i0 = pn; u.i1 = pm; u.i2 = 1; u.i3 = 0; return true; } };
__device__ __forceinline__ void ph_g1(const Prm& p, int l, LAS unsigned char* lds) {
    unsigned char* ws = p.ws; const int lat = (l == NLAYER - 1) ? 1 : 0;
    { SchedG1g S{(const bf16_t*)(ws + O_H8G), (const bf16_t*)(ws + O_WG8 + (size_t)l * 3072 * DM), nblk_(), bid_(), lat}; EpiGate E{(bf16_t*)(ws + O_PM)}; gemm_fast<false, 0, true>(lds, S, E, 512, 512, 8); }
    { SchedG1a S{(const bf16_t*)(ws + O_H8G), (const bf16_t*)(ws + O_WINM) + (size_t)l * PMW * DM, nblk_(), bid_(), lat}; EpiPm E{(bf16_t*)(ws + O_PM), (bf16_t*)(ws + O_QP), (bf16_t*)(ws + O_KP), p.q_gain + l * 64, p.k_gain + l * 64, (const float*)(ws + O_ROPE)}; gemm_fast<false, 0, true>(lds, S, E, 512, 512, 8); }
    { SchedG1b S{(const bf16_t*)(ws + O_H), (const bf16_t*)(ws + O_WINS) + (size_t)l * SWR * DM, nblk_(), bid_(), lat}; EpiSw E{(bf16_t*)(ws + O_HYT), (bf16_t*)(ws + O_HYTC), (bf16_t*)(ws + O_PQT), (bf16_t*)(ws + O_PQTC)}; gemm_fast<false>(lds, S, E, DM, DM, 16); }
}
__device__ __forceinline__ void ph_fnet(const Prm& p, int l, LAS unsigned char* lds) {
    unsigned char* ws = p.ws; EpiBf E{(bf16_t*)(ws + O_MIX), DM, 1.0f};
    { SchedFnL S{(const bf16_t*)(ws + O_DFTM), (const bf16_t*)(ws + O_PQT), nblk_(), bid_()}; gemm_fast<false>(lds, S, E, 4096, 4096, 64); }
    if (l != NLAYER - 1) { SchedFnC S{(const bf16_t*)(ws + O_DFTC), (const bf16_t*)(ws + O_PQTC), nblk_(), bid_()}; gemm_fast<false>(lds, S, E, 512, 512, 8); }
}
__device__ __forceinline__ void ph_merge_part(const Prm& p, int l, LAS unsigned char* lds, int lat, int p0, int np) {
    unsigned char* ws = p.ws; EpiMerge E{(const bf16_t*)(ws + O_PM), (bf16_t*)(ws + O_M)};
    SchedSq S{(const bf16_t*)(ws + O_MIX), (const bf16_t*)(ws + O_WBT) + (size_t)l * DM * DM, nblk_(), bid_(), lat, p0, np, 0};
    gemm_fast<false, 1>(lds, S, E, DM, DM, 16);
}
__device__ __forceinline__ void ph_wout_part(const Prm& p, int l, LAS unsigned char* lds, int lat, int p0, int np, int rev) {
    unsigned char* ws = p.ws; SchedSq S{(const bf16_t*)(ws + O_M), (const bf16_t*)(ws + O_WOT) + (size_t)l * DM * DM, nblk_(), bid_(), lat, p0, np, rev};
    EpiY E{(bf16_t*)(ws + O_MIX)};
    gemm_fast<false>(lds, S, E, DM, DM, 16);
}
__device__ __forceinline__ void ph_moe_up(const Prm& p, int l, LAS unsigned char* lds) {
    unsigned char* ws = p.ws; SchedUp S{(const bf16_t*)(ws + O_XG8), (const bf16_t*)(ws + O_WGU + (size_t)l * NEXP * 4096 * DM), (const int*)(ws + O_IDX), nblk_(), bid_(), (l == NLAYER - 1) ? 16 : 18};
    EpiGlu E{(unsigned char*)(ws + O_HID)};
    gemm_fast<false, 0, true>(lds, S, E, 512, 512, 8);
}
__device__ __forceinline__ void ph_moe_down(const Prm& p, int l, LAS unsigned char* lds) {
    unsigned char* ws = p.ws; SchedDown S{(const bf16_t*)(ws + O_HID), (const bf16_t*)(ws + O_WDT + (size_t)l * NEXP * DM * FF), nblk_(), bid_(), (l == NLAYER - 1) ? 16 : 18};
    EpiF8 E{(unsigned char*)(ws + O_Y), DM, (W8I / H8S) * Y8S};
    gemm_fast<false, 0, true>(lds, S, E, 1024, 1024, 16);
}

#define XB_TMO      128
#define XB_XCNT(j)  (256  + 64 * (j))
#define XB_XSUB(j)  (1280 + 64 * (j))
#define XB_XGEN(j)  (2304 + 64 * (j))
#define XB_TOP      3328
#define XB_TOPGEN   3392
#define XCD_BAR_WORDS 3456
#define XB_SPIN_CAP (1u << 18)
__device__ __forceinline__ unsigned xb_ld(unsigned* p)              { return __hip_atomic_load(p, __ATOMIC_RELAXED, __HIP_MEMORY_SCOPE_AGENT); }
__device__ __forceinline__ unsigned xb_add(unsigned* p, unsigned v) { return __hip_atomic_fetch_add(p, v, __ATOMIC_RELAXED, __HIP_MEMORY_SCOPE_AGENT); }
__device__ __forceinline__ unsigned xb_xcc_id() { return (unsigned)__builtin_amdgcn_s_getreg((3 << 11) | 20) & 0xFu; }
#define XB_SPIN(cond, bar) do { unsigned _sp = 0; while (cond) { __builtin_amdgcn_s_sleep(1); \
    if ((++_sp & 255u) == 0u) { if (xb_ld(&(bar)[XB_TMO])) break; if (_sp > XB_SPIN_CAP) { atomicAdd(&(bar)[XB_TMO], 1u); break; } } } } while (0)
struct XcdBarrier { unsigned* bar; unsigned x; volatile LAS unsigned* st; };
__device__ __forceinline__ XcdBarrier xcd_barrier_post(unsigned* bar, volatile LAS unsigned* st) {
    XcdBarrier b; b.bar = bar; b.x = xb_xcc_id(); b.st = st;
    if (threadIdx.x == 0) (void)xb_add(&bar[XB_XCNT(b.x)], 1u);
    return b;
}
__device__ __forceinline__ void xcd_barrier_complete(unsigned* bar, unsigned x, unsigned& nloc, unsigned& nx) {
    const unsigned G = gridDim.x * gridDim.y * gridDim.z;
    unsigned sum, cnt, mine, sp = 0u;
    for (;;) {
        sum = 0u; cnt = 0u; mine = 0u;
#pragma unroll
        for (unsigned j = 0; j < 16; ++j) { const unsigned c = xb_ld(&bar[XB_XCNT(j)]); sum += c; cnt += (c > 0u) ? 1u : 0u; mine = (j == x) ? c : mine; }
        if (sum == G) break;
        __builtin_amdgcn_s_sleep(1);
        if ((++sp & 255u) == 0u) { if (xb_ld(&bar[XB_TMO])) break; if (sp > XB_SPIN_CAP) { atomicAdd(&bar[XB_TMO], 1u); break; } }
    }
    nloc = mine > 0u ? mine : 1u; nx = cnt > 0u ? cnt : 1u;
}
__device__ __forceinline__ void xcd_barrier(const XcdBarrier& b) {
    asm volatile("s_waitcnt vmcnt(0)" ::: "memory");
    __syncthreads();
    if (threadIdx.x == 0) {
        unsigned* bar = b.bar;
        __builtin_amdgcn_s_waitcnt(0);
        unsigned nloc = b.st[0], nx = b.st[1];
        if (nloc == 0u) { xcd_barrier_complete(bar, b.x, nloc, nx); b.st[0] = nloc; b.st[1] = nx; }
        const unsigned old = xb_add(&bar[XB_XSUB(b.x)], 1u);
        const unsigned gen = old / nloc;
        if (old + 1u == (gen + 1u) * nloc) {
            __builtin_amdgcn_fence(__ATOMIC_RELEASE, "agent");
            asm volatile("s_waitcnt vmcnt(0)" ::: "memory");
            const unsigned og = xb_add(&bar[XB_TOP], 1u);
            const unsigned tg = og / nx;
            if (og + 1u == (tg + 1u) * nx) xb_add(&bar[XB_TOPGEN], 1u);
            else XB_SPIN(xb_ld(&bar[XB_TOPGEN]) == tg, bar);
            __builtin_amdgcn_fence(__ATOMIC_ACQUIRE, "agent");
            xb_add(&bar[XB_XGEN(b.x)], 1u);
            asm volatile("s_waitcnt vmcnt(0)" ::: "memory");
        } else {
            XB_SPIN(xb_ld(&bar[XB_XGEN(b.x)]) == gen, bar);
            __builtin_amdgcn_fence(__ATOMIC_ACQUIRE, "agent");
            asm volatile("s_waitcnt vmcnt(0)" ::: "memory");
        }
    }
    __syncthreads();
}


struct SchedOne { GU u; __device__ __forceinline__ bool next(int i, GU& o) const { if (i != 0) return false; o = u; return true; } };
template <int N> __device__ __forceinline__ void fnet_fold_unit(const bf16_t* src, bf16_t* dst, int nch) {
    constexpr int CPH = N / 16, CPR = N / 8;
    const int tid = tid_();
    for (int q = tid; q < nch * CPR; q += NT) {
        const int ch = q / CPR, cc = q % CPR, hf = cc >= CPH ? 1 : 0, c = cc - hf * CPH;
        const bf16_t* row = src + (size_t)ch * (2 * N); const bf16_t* base = row + hf * N;
        const u32x4 V = *(const u32x4*)(base + 8 * c), M0 = *(const u32x4*)(base + (N - 8 * c - 8)), M1 = *(const u32x4*)(base + (N - 8 * c));
        const bf16_t pn2 = row[N / 2];
        float v[8], m0[8], o[8]; unpk8(V, v); unpk8(M0, m0); const float m1 = bflo(M1.x);
        const float sg = hf ? -1.0f : 1.0f;
        o[0] = v[0] + sg * m1;
#pragma unroll
        for (int i = 1; i < 8; ++i) o[i] = v[i] + sg * m0[8 - i];
        if (c == 0) o[0] = hf ? bf2f(pn2) : v[0];
        *(u32x4*)(dst + (size_t)ch * N + hf * (N / 2) + 8 * c) = (u32x4){pk2(o[0], o[1]), pk2(o[2], o[3]), pk2(o[4], o[5]), pk2(o[6], o[7])};
    }
    __builtin_amdgcn_fence(__ATOMIC_RELEASE, "agent");
    __syncthreads();
}
__device__ __forceinline__ void flag_up(unsigned* f) { if (threadIdx.x == 0) __hip_atomic_fetch_add(f, 1u, __ATOMIC_RELAXED, __HIP_MEMORY_SCOPE_AGENT); }
__device__ __forceinline__ void flag_wait(unsigned* f, unsigned target) {
    if (threadIdx.x == 0) { while (__hip_atomic_load(f, __ATOMIC_RELAXED, __HIP_MEMORY_SCOPE_AGENT) < target) __builtin_amdgcn_s_sleep(8); }
    __syncthreads();
    __builtin_amdgcn_fence(__ATOMIC_ACQUIRE, "agent");
}
__device__ __forceinline__ float attn_negc(const Prm& p, int l) {
    const int lane = tid_() & 63;
    float gq = fabsf(p.q_gain[l * 64 + lane]), gk = fabsf(p.k_gain[l * 64 + lane]);
#pragma unroll
    for (int o = 32; o; o >>= 1) { gq = fmaxf(gq, __shfl_xor(gq, o)); gk = fmaxf(gk, __shfl_xor(gk, o)); }
    return __builtin_bit_cast(float, __builtin_amdgcn_readfirstlane(__builtin_bit_cast(int, -(64.0f * 0.125f * 1.4426950408889634f * 1.02f) * gq * gk)));
}
__device__ __forceinline__ void ph_mix(const Prm& p, int l, LAS unsigned char* lds, char* shm, int qset = 0) {
    using attn_body::bf16;
    unsigned char* ws = p.ws; const bool lastl = (l == NLAYER - 1); const int nper = lastl ? 168 : 220;
    unsigned* qbase = (unsigned*)(ws + O_QCNT) + 64 * (1 + l * 8 + qset * 32);
    LAS unsigned* slot = (LAS unsigned*)(lds + LDS_BYTES - 32);
    const int myx = (int)(xb_xcc_id() & 7u);
#pragma unroll 1
    for (int sx = 0; sx < 8; ++sx) {
        const int x = (myx + sx) & 7;
        __syncthreads();
        if (threadIdx.x == 0) *slot = atomicAdd(qbase + 64 * x, 1u);
        __syncthreads();
#pragma unroll 1
        for (;;) {
            const int u = (int)__builtin_amdgcn_readfirstlane(*slot);
            if (u >= nper) break;
            unsigned nxtu = 0u; if (threadIdx.x == 0) nxtu = atomicAdd(qbase + 64 * x, 1u);
            __syncthreads();
            unsigned* flg = (unsigned*)(ws + O_FLAG) + l * 32;
            if (u < 8) {
                const int fb = x * 2 + (u >> 2), c0 = (u & 3) * 64;
                fnet_fold_unit<LSEQ>((const bf16_t*)(ws + O_PQT) + ((size_t)fb * 256 + c0) * 4096, (bf16_t*)(ws + O_PQF) + ((size_t)fb * 256 + c0) * LSEQ, 64); flag_up(flg + fb);
            } else if (u < 24) { hyena_pair_unit(p, l, (x * 16 + (u - 8)) * 2, lds);
            } else if (u < 88 || (u >= 104 && u < 168)) {
                const int v = u < 88 ? u - 24 : u - 104 + 64, id = x * 4 + (v >> 5), sl = v & 31, b = id >> 1, g = id & 1, h = g * 4 + (sl >> 3); const long qrow0 = (long)b * TPB + (sl & 7) * 256, krow0 = (long)b * TPB;
                attn_body::attn_unit<9999, 512, 128, PMW, DM>((const bf16*)(ws + O_QP) + qrow0 * 512 + h * 64, (const bf16*)(ws + O_KP) + krow0 * 128 + g * 64, (const bf16*)(ws + O_PM) + krow0 * PMW + 640 + g * 64, (bf16*)(ws + O_MIX) + qrow0 * DM + h * 64, 36, shm, attn_negc(p, l));
            } else if (u < 104) {
                SchedOne S; S.u.gidx = nullptr; S.u.lda = 2048; S.u.ldb = 2048; S.u.nt = 32; S.u.i1 = 768; S.u.i2 = 0; S.u.i3 = 0;
                const int w = u - 88, fb = x * 2 + (w >> 3), fpm = w & 7;
                flag_wait(flg + fb, 4u);
                S.u.A = (const bf16_t*)(ws + O_DFTM) + (size_t)fpm * BM * 2048; S.u.B = (const bf16_t*)(ws + O_PQF) + (size_t)fb * 256 * 2048; S.u.i0 = fb * TPB + fpm * 256;
                EpiBf E{(bf16_t*)(ws + O_MIX), DM, 1.0f}; gemm_fast<false>(lds, S, E, 2048, 2048, 32);
            } else if (u < 170) {
                const int b = x * 2 + (u - 168);
                fnet_fold_unit<LCTX>((const bf16_t*)(ws + O_PQTC) + (size_t)b * 256 * 512, (bf16_t*)(ws + O_PQFC) + (size_t)b * 256 * LCTX, 256); flag_up(flg + 16 + b);
            } else if (u < 202) { hyena_mfma_unit<LCTX, 2>(p, l, x * 32 + (u - 170), lds);
            } else if (u < 218) {
                const int j = x * 16 + (u - 202), b = j >> 3, h = j & 7, g = h >> 2; const long qrow0 = (long)b * TPB + LSEQ;
                attn_body::attn_unit<9999, 512, 128, PMW, DM>((const bf16*)(ws + O_QP) + qrow0 * 512 + h * 64, (const bf16*)(ws + O_KP) + qrow0 * 128 + g * 64, (const bf16*)(ws + O_PM) + qrow0 * PMW + 640 + g * 64, (bf16*)(ws + O_MIX) + qrow0 * DM + h * 64, 4, shm, attn_negc(p, l));
            } else {
                const int b = x * 2 + (u - 218);
                SchedOne S; S.u.gidx = nullptr; S.u.lda = 256; S.u.ldb = 256; S.u.nt = 4; S.u.i1 = 768; S.u.i2 = 0; S.u.i3 = 0;
                flag_wait(flg + 16 + b, 1u);
                S.u.A = (const bf16_t*)(ws + O_DFTC); S.u.B = (const bf16_t*)(ws + O_PQFC) + (size_t)b * 256 * 256; S.u.i0 = b * TPB + LSEQ;
                EpiBf E{(bf16_t*)(ws + O_MIX), DM, 1.0f}; gemm_fast<false>(lds, S, E, 256, 256, 4);
            }
            __syncthreads();
            if (threadIdx.x == 0) *slot = nxtu;
            __syncthreads();
        }
    }
}

__device__ __forceinline__ const Prm& kprm() { auto k = __builtin_amdgcn_kernarg_segment_ptr(); asm volatile("" : "+s"(k)); return *(const Prm*)k; }
#define P_ kprm()
__global__ void __launch_bounds__(NT, 2) k_mega(Prm p_unused) {
    extern __shared__ __attribute__((aligned(16))) unsigned char shm[];
    LAS unsigned char* lds = (LAS unsigned char*)shm;
    volatile LAS unsigned* st = (volatile LAS unsigned*)(lds + LDS_BYTES - 16);
    if (threadIdx.x == 0) { st[0] = 0u; st[1] = 0u; st[2] = 0u; st[3] = 0u; }
    __syncthreads();
    (void)xcd_barrier_post((unsigned*)(P_.ws + O_BAR), st);
#define GSYNC() do { XcdBarrier b_; b_.bar = (unsigned*)(P_.ws + O_BAR); b_.x = xb_xcc_id(); b_.st = (volatile LAS unsigned*)(lds + LDS_BYTES - 16); xcd_barrier(b_); } while (0)
    ph_pre1<-1>(P_, lds);
    GSYNC();
    ph_pre2(P_, lds);
    GSYNC();
#pragma unroll 1
    for (int l = 0; l < NLAYER; ++l) {
        ph_norm1(P_, l, lds);            GSYNC();
        ph_g1(P_, l, lds);               GSYNC();
        ph_mix(P_, l, lds, (char*)shm);  GSYNC();
        if (l == NLAYER - 1) { ph_merge_part(P_, l, lds, 1, 0, 128); GSYNC(); ph_wout_part(P_, l, lds, 1, 0, 128, 0); GSYNC(); }
        else { ph_merge_part(P_, l, lds, 0, 0, 128); GSYNC(); ph_merge_part(P_, l, lds, 0, 128, 16); ph_wout_part(P_, l, lds, 0, 0, 112, 1); GSYNC(); ph_wout_part(P_, l, lds, 0, 112, 32, 0); GSYNC(); }
        ph_norm2(P_, l, lds);            GSYNC();
        ph_topk(P_, l, lds);             GSYNC();
        ph_moe_up(P_, l, lds);           GSYNC();
        ph_moe_down(P_, l, lds);         GSYNC();
    }
    ph_norm1(P_, NLAYER, lds);
}

extern "C" void kernel_launch(void* const* d_in, const int* in_sizes, int n_in, void* d_out, int out_size, void* d_ws, size_t ws_size, hipStream_t stream) {
    Prm p; memset(&p, 0, sizeof(p));
    const float** f = (const float**)&p;
    for (int i = 0; i < 27; ++i) f[i] = (const float*)d_in[i];
    p.out = (float*)d_out; p.ws = (unsigned char*)d_ws;
    static int grid = 0;
    if (!grid) {
        int dev = 0, cus = 0, per_cu = 0;
        (void)hipGetDevice(&dev);
        (void)hipDeviceGetAttribute(&cus, hipDeviceAttributeMultiprocessorCount, dev);
        (void)hipFuncSetAttribute((const void*)k_mega, hipFuncAttributeMaxDynamicSharedMemorySize, LDS_BYTES);
        (void)hipOccupancyMaxActiveBlocksPerMultiprocessor(&per_cu, k_mega, NT, LDS_BYTES);
        if (cus <= 0) cus = 256;
        grid = cus * (per_cu < 1 ? 1 : 1);
    }
    (void)hipMemsetAsync((unsigned char*)d_ws + O_BAR, 0, 65536, stream);
    hipLaunchKernelGGL(k_mega, dim3(grid), dim3(NT), LDS_BYTES, stream, p);
}
```
